# Optimizing an MI355X kernel written in HIP

```python
import jax
import jax.numpy as jnp
from jax import lax
import numpy as np

D_MODEL = 2048
BATCH = 4
SEQ = 8192
DEPTH = 2

N_MIXERS = 2
N_RET_LAYERS = (DEPTH + 1) // 2
N_MLA_LAYERS = DEPTH // 2
EPS = 1e-6
ROPE_BASE = 10000.0
BLOCK = 128

RET_HEADS = 8
RET_DK = D_MODEL // RET_HEADS
RET_DV = 2 * RET_DK
RET_WIDTH = RET_HEADS * RET_DV
RET_QK = RET_HEADS * RET_DK
RET_IN = 2 * RET_QK + 2 * RET_WIDTH

MLA_HEADS = 16
MLA_NOPE = 128
MLA_ROPE = 64
MLA_V = 128
MLA_Q_RANK = 512
MLA_KV_RANK = 512
MLA_WIDTH = MLA_HEADS * MLA_V
MLA_IN = MLA_Q_RANK + MLA_KV_RANK + MLA_ROPE + MLA_WIDTH

kernel_name = "hybrid_retention_mla_adaln"


def rmsnorm(x, g):
    xf = x.astype(jnp.float32)
    y = xf * lax.rsqrt(jnp.mean(xf * xf, axis=-1, keepdims=True) + EPS)
    return (y * g.astype(jnp.float32)).astype(x.dtype)


def rope(x, pos):
    d = x.shape[-1]
    inv_freq = ROPE_BASE ** (-jnp.arange(0, d, 2, dtype=jnp.float32) / d)
    ang = pos.astype(jnp.float32)[:, :, None, None] * inv_freq
    cos = jnp.cos(ang).astype(x.dtype)
    sin = jnp.sin(ang).astype(x.dtype)
    x1, x2 = x[..., : d // 2], x[..., d // 2:]
    return jnp.concatenate([x1 * cos - x2 * sin, x2 * cos + x1 * sin], axis=-1)


def chunkwise_retention(q, k, v):
    B, S, H, _ = q.shape
    nc = S // BLOCK
    log_gamma = jnp.log1p(-jnp.exp2(-5.0 - jnp.arange(H, dtype=jnp.float32)))
    idx = jnp.arange(BLOCK, dtype=jnp.float32)
    diff = idx[:, None] - idx[None, :]
    d_intra = jnp.where(diff >= 0, jnp.exp(log_gamma[:, None, None] * jnp.maximum(diff, 0.0)), 0.0)
    xi = jnp.exp(log_gamma[:, None] * (idx + 1.0))[None, :, :, None]
    zeta = jnp.exp(log_gamma[:, None] * (BLOCK - 1.0 - idx))[None, :, :, None]
    chunk_decay = jnp.exp(log_gamma * BLOCK)[None, :, None, None]

    def to_chunks(t):
        return t.astype(jnp.float32).reshape(B, nc, BLOCK, H, t.shape[-1]).transpose(1, 0, 3, 2, 4)

    def step(state, inp):
        qi, ki, vi = inp
        scores = jnp.einsum('bhnd,bhmd->bhnm', qi, ki) * d_intra
        inner = jnp.einsum('bhnm,bhmv->bhnv', scores, vi)
        cross = jnp.einsum('bhnd,bhdv->bhnv', qi, state) * xi
        state = state * chunk_decay + jnp.einsum('bhmd,bhmv->bhdv', ki, vi * zeta)
        return state, inner + cross

    state0 = jnp.zeros((B, H, q.shape[-1], v.shape[-1]), jnp.float32)
    _, out = lax.scan(step, state0, (to_chunks(q), to_chunks(k), to_chunks(v)))
    return out.transpose(1, 0, 3, 2, 4).reshape(B, S, H, v.shape[-1])


def retention_branch(h, pos, w_in, gn_g, w_out):
    B, S, _ = h.shape
    proj = h @ w_in
    q, k, v, g = jnp.split(proj, [RET_QK, 2 * RET_QK, 2 * RET_QK + RET_WIDTH], axis=-1)
    q = rope(q.reshape(B, S, RET_HEADS, RET_DK), pos)
    k = rope(k.reshape(B, S, RET_HEADS, RET_DK), pos) * (RET_DK ** -0.5)
    v = v.reshape(B, S, RET_HEADS, RET_DV)
    y = chunkwise_retention(q, k, v)
    mu = jnp.mean(y, axis=-1, keepdims=True)
    var = jnp.mean(jnp.square(y - mu), axis=-1, keepdims=True)
    y = (y - mu) * lax.rsqrt(var + EPS)
    y = (y.reshape(B, S, RET_WIDTH) * gn_g.astype(jnp.float32)).astype(h.dtype)
    return (jax.nn.silu(g) * y) @ w_out


def causal_block_attention(q, k, v):
    B, S, H, dq = q.shape
    nb = S // BLOCK
    scale = dq ** -0.5
    qb = q.reshape(B, nb, BLOCK, H, dq).transpose(1, 0, 3, 2, 4)
    kt = k.transpose(0, 2, 1, 3)
    vt = v.transpose(0, 2, 1, 3)
    key_pos = jnp.arange(S)

    def one_block(args):
        i, qi = args
        s = jnp.einsum('bhqd,bhkd->bhqk', qi, kt).astype(jnp.float32) * scale
        qpos = i * BLOCK + jnp.arange(BLOCK)
        s = jnp.where(key_pos[None, :] <= qpos[:, None], s, -1e30)
        p = jax.nn.softmax(s, axis=-1).astype(vt.dtype)
        return jnp.einsum('bhqk,bhkd->bhqd', p, vt)

    o = lax.map(one_block, (jnp.arange(nb), qb))
    return o.transpose(1, 0, 3, 2, 4).reshape(B, S, H, v.shape[-1])


def mla_branch(h, pos, w_in, q_norm_g, w_uq, kv_norm_g, w_ukv, w_out):
    B, S, _ = h.shape
    proj = h @ w_in
    cq, ckv, k_rope, g = jnp.split(
        proj, [MLA_Q_RANK, MLA_Q_RANK + MLA_KV_RANK, MLA_Q_RANK + MLA_KV_RANK + MLA_ROPE], axis=-1)
    q = (rmsnorm(cq, q_norm_g) @ w_uq).reshape(B, S, MLA_HEADS, MLA_NOPE + MLA_ROPE)
    q = jnp.concatenate([q[..., :MLA_NOPE], rope(q[..., MLA_NOPE:], pos)], axis=-1)
    kv = (rmsnorm(ckv, kv_norm_g) @ w_ukv).reshape(B, S, MLA_HEADS, MLA_NOPE + MLA_V)
    k_nope, v = kv[..., :MLA_NOPE], kv[..., MLA_NOPE:]
    k_rope = rope(k_rope[:, :, None, :], pos)
    k = jnp.concatenate([k_nope, jnp.broadcast_to(k_rope, (B, S, MLA_HEADS, MLA_ROPE))], axis=-1)
    o = causal_block_attention(q, k, v).reshape(B, S, MLA_WIDTH)
    return (jax.nn.silu(g) * o) @ w_out


def setup_inputs(seed: int = 0) -> dict:
    key = jax.random.key(seed)
    ks = jax.random.split(key, 18)

    def w(k, shape, fan_in, gain=1.0):
        return jax.random.normal(k, shape, jnp.float32) * (gain * fan_in ** -0.5)

    def gain(k, shape):
        return 1.0 + 0.05 * jax.random.normal(k, shape, jnp.float32)

    x = jax.random.normal(ks[0], (BATCH, SEQ, D_MODEL), jnp.float32)
    c = jax.random.normal(ks[1], (BATCH, D_MODEL), jnp.float32)
    start = jax.random.randint(ks[2], (BATCH, 1), 0, 1024, dtype=jnp.int32)
    positions = start + jnp.arange(SEQ, dtype=jnp.int32)[None, :]
    return {
        "x": x,
        "c": c,
        "positions": positions,
        "ada_w": w(ks[3], (DEPTH, D_MODEL, 3 * D_MODEL), D_MODEL, 0.5),
        "ada_b": 0.01 * jax.random.normal(ks[4], (DEPTH, 3 * D_MODEL), jnp.float32),
        "norm_g": gain(ks[5], (DEPTH, D_MODEL)),
        "ret_w_in": w(ks[6], (N_RET_LAYERS, D_MODEL, RET_IN), D_MODEL),
        "ret_gn_g": gain(ks[7], (N_RET_LAYERS, RET_WIDTH)),
        "ret_w_out": w(ks[8], (N_RET_LAYERS, RET_WIDTH, D_MODEL), RET_WIDTH),
        "mla_w_in": w(ks[9], (N_MLA_LAYERS, D_MODEL, MLA_IN), D_MODEL),
        "mla_q_norm_g": gain(ks[10], (N_MLA_LAYERS, MLA_Q_RANK)),
        "mla_w_uq": w(ks[11], (N_MLA_LAYERS, MLA_Q_RANK, MLA_HEADS * (MLA_NOPE + MLA_ROPE)), MLA_Q_RANK),
        "mla_kv_norm_g": gain(ks[12], (N_MLA_LAYERS, MLA_KV_RANK)),
        "mla_w_ukv": w(ks[13], (N_MLA_LAYERS, MLA_KV_RANK, MLA_HEADS * (MLA_NOPE + MLA_V)), MLA_KV_RANK),
        "mla_w_out": w(ks[14], (N_MLA_LAYERS, MLA_WIDTH, D_MODEL), MLA_WIDTH),
        "final_norm_g": gain(ks[15], (D_MODEL,)),
    }


def reference(x, c, positions, ada_w, ada_b, norm_g, ret_w_in, ret_gn_g, ret_w_out,
              mla_w_in, mla_q_norm_g, mla_w_uq, mla_kv_norm_g, mla_w_ukv, mla_w_out,
              final_norm_g):
    c_act = jax.nn.silu(c)
    for i in range(DEPTH):
        mod = (c_act @ ada_w[i] + ada_b[i])[:, None, :]
        shift, scale, gate = jnp.split(mod, 3, axis=-1)
        h = rmsnorm(x, norm_g[i]) * (1.0 + scale) + shift
        j = i // N_MIXERS
        if i % N_MIXERS == 0:
            y = retention_branch(h, positions, ret_w_in[j], ret_gn_g[j], ret_w_out[j])
        else:
            y = mla_branch(h, positions, mla_w_in[j], mla_q_norm_g[j], mla_w_uq[j],
                           mla_kv_norm_g[j], mla_w_ukv[j], mla_w_out[j])
        x = x + gate * y
    return rmsnorm(x, final_norm_g)
```

```cpp
#include <hip/hip_runtime.h>
#include <hip/hip_bf16.h>
#include <hip/hip_cooperative_groups.h>
#include <cstdio>
#include <cstdint>
namespace cg = cooperative_groups;

constexpr int BATCH = 4, SEQ = 8192, DM = 2048, T = BATCH * SEQ;
constexpr int RET_H = 8, RET_DK = 256, RET_DV = 512, RET_W = 4096, RET_QK = 2048, RET_IN = 12288;
constexpr int MLA_H = 16, MLA_NOPE = 128, MLA_ROPE = 64, MLA_V = 128, MLA_QR = 512, MLA_KVR = 512, MLA_W = 2048, MLA_IN = 3136, MLA_INP = 3328;
constexpr float EPS = 1e-6f;
constexpr size_t MiB = 1u << 20;
constexpr size_t WS_WRIN = 0 * MiB, WS_WROUT = 48 * MiB, WS_WMIN = 64 * MiB, WS_WUQ = 77 * MiB, WS_WUKV = 80 * MiB, WS_WMOUT = 84 * MiB;
constexpr size_t WS_CTL = 92 * MiB;
constexpr size_t CTL_MOD = 0, CTL_SSQQ = 256 * 1024, CTL_SSQKV = 384 * 1024;
constexpr size_t WS_H = 96 * MiB;
constexpr size_t WS_Q = 224 * MiB, WS_K = 352 * MiB, WS_V = 480 * MiB, WS_SG = 736 * MiB;
constexpr size_t WS_CQ = 224 * MiB, WS_CKV = 256 * MiB, WS_KR = 288 * MiB, WS_SG1 = 296 * MiB, WS_QN = 424 * MiB, WS_QRP = 552 * MiB, WS_KN = 616 * MiB, WS_V1 = 744 * MiB;
constexpr size_t WS_END = 992 * MiB;

#define LAS __attribute__((address_space(3)))
typedef unsigned short bf16_t;
typedef short bf16x8 __attribute__((ext_vector_type(8)));
typedef short s16x4 __attribute__((ext_vector_type(4)));
typedef float f32x4 __attribute__((ext_vector_type(4)));
typedef float f32x16 __attribute__((ext_vector_type(16)));
typedef unsigned u32x4 __attribute__((ext_vector_type(4)));
typedef unsigned u32x2 __attribute__((ext_vector_type(2)));

__device__ __forceinline__ unsigned cvtpk(float lo, float hi) { unsigned r; asm volatile("v_cvt_pk_bf16_f32 %0, %1, %2" : "=v"(r) : "v"(lo), "v"(hi)); return r; }
__device__ __forceinline__ float bf2f(unsigned short b) { return __uint_as_float(((unsigned)b) << 16); }
__device__ __forceinline__ float bflo(unsigned w) { return __uint_as_float(w << 16); }
__device__ __forceinline__ float bfhi(unsigned w) { return __uint_as_float(w & 0xffff0000u); }
__device__ __forceinline__ float silu_f(float v) { return v / (1.0f + __expf(-v)); }
__device__ __forceinline__ float wave_sum(float v) {
#pragma unroll
    for (int o = 1; o < 64; o <<= 1) v += __shfl_xor(v, o);
    return v;
}
__device__ __forceinline__ void sincos_rr(float ang, float& s, float& c) {
    const float k = rintf(ang * 0.15915494309189535f);
    float r = fmaf(-k, 6.2831854820251465f, ang);
    r = fmaf(-k, -1.7484555e-7f, r);
    const float rev = r * 0.15915494309189535f;
    s = __builtin_amdgcn_sinf(rev); c = __builtin_amdgcn_cosf(rev);
}

__device__ const float INVF256[128] __attribute__((aligned(16))) = {1.000000000e+00f, 9.305720329e-01f, 8.659643531e-01f, 8.058421612e-01f, 7.498942018e-01f, 6.978305578e-01f, 6.493816376e-01f, 6.042963862e-01f, 5.623413324e-01f, 5.232990980e-01f, 4.869675338e-01f, 4.531583786e-01f, 4.216965139e-01f, 3.924189806e-01f, 3.651741147e-01f, 3.398208320e-01f, 3.162277639e-01f, 2.942727208e-01f, 2.738419771e-01f, 2.548296750e-01f, 2.371373773e-01f, 2.206734121e-01f, 2.053525001e-01f, 1.910952926e-01f, 1.778279394e-01f, 1.654817164e-01f, 1.539926529e-01f, 1.433012635e-01f, 1.333521456e-01f, 1.240937784e-01f, 1.154781953e-01f, 1.074607819e-01f, 1.000000015e-01f, 9.305720776e-02f, 8.659642935e-02f, 8.058422059e-02f, 7.498942316e-02f, 6.978306174e-02f, 6.493816525e-02f, 6.042964011e-02f, 5.623413250e-02f, 5.232991278e-02f, 4.869675264e-02f, 4.531583562e-02f, 4.216964915e-02f, 3.924189880e-02f, 3.651741147e-02f, 3.398208320e-02f, 3.162277490e-02f, 2.942727134e-02f, 2.738419548e-02f, 2.548296750e-02f, 2.371373773e-02f, 2.206734009e-02f, 2.053525113e-02f, 1.910953037e-02f, 1.778279431e-02f, 1.654817164e-02f, 1.539926510e-02f, 1.433012541e-02f, 1.333521400e-02f, 1.240937784e-02f, 1.154781971e-02f, 1.074607857e-02f, 9.999999776e-03f, 9.305720218e-03f, 8.659643121e-03f, 8.058422245e-03f, 7.498942316e-03f, 6.978305988e-03f, 6.493816152e-03f, 6.042963825e-03f, 5.623413250e-03f, 5.232991185e-03f, 4.869675264e-03f, 4.531583749e-03f, 4.216964822e-03f, 3.924189601e-03f, 3.651741194e-03f, 3.398208413e-03f, 3.162277630e-03f, 2.942727180e-03f, 2.738419687e-03f, 2.548296703e-03f, 2.371373819e-03f, 2.206734149e-03f, 2.053525066e-03f, 1.910952968e-03f, 1.778279431e-03f, 1.654817141e-03f, 1.539926510e-03f, 1.433012541e-03f, 1.333521446e-03f, 1.240937738e-03f, 1.154782018e-03f, 1.074607833e-03f, 1.000000047e-03f, 9.305720450e-04f, 8.659643354e-04f, 8.058421663e-04f, 7.498941850e-04f, 6.978305755e-04f, 6.493816036e-04f, 6.042963942e-04f, 5.623413017e-04f, 5.232990952e-04f, 4.869675322e-04f, 4.531583691e-04f, 4.216965172e-04f, 3.924189659e-04f, 3.651741135e-04f, 3.398208355e-04f, 3.162277571e-04f, 2.942727297e-04f, 2.738419571e-04f, 2.548296761e-04f, 2.371373703e-04f, 2.206734061e-04f, 2.053525095e-04f, 1.910952997e-04f, 1.778279402e-04f, 1.654817170e-04f, 1.539926598e-04f, 1.433012512e-04f, 1.333521504e-04f, 1.240937709e-04f, 1.154782003e-04f, 1.074607862e-04f};
__device__ const float INVF64[32] __attribute__((aligned(16))) = {1.000000000e+00f, 7.498942018e-01f, 5.623413324e-01f, 4.216965139e-01f, 3.162277639e-01f, 2.371373773e-01f, 1.778279394e-01f, 1.333521456e-01f, 1.000000015e-01f, 7.498942316e-02f, 5.623413250e-02f, 4.216964915e-02f, 3.162277490e-02f, 2.371373773e-02f, 1.778279431e-02f, 1.333521400e-02f, 9.999999776e-03f, 7.498942316e-03f, 5.623413250e-03f, 4.216964822e-03f, 3.162277630e-03f, 2.371373819e-03f, 1.778279431e-03f, 1.333521446e-03f, 1.000000047e-03f, 7.498941850e-04f, 5.623413017e-04f, 4.216965172e-04f, 3.162277571e-04f, 2.371373703e-04f, 1.778279402e-04f, 1.333521504e-04f};
namespace pg8 {
#define PG8_LAS __attribute__((address_space(3)))
typedef unsigned short bf16_t;
typedef short bf16x8 __attribute__((ext_vector_type(8)));
typedef float f32x4 __attribute__((ext_vector_type(4)));
typedef unsigned u32x4 __attribute__((ext_vector_type(4)));
constexpr int BM = 256, BK = 64, HALF = 128, HTB = HALF * BK * 2  , STAGE_BYTES = 8 * HTB, NXCD = 8, WGM = 8;

__host__ __device__ __forceinline__ int lds_byte(int r, int c) { const int st = (r >> 4) * 2 + (c >> 5), rr = r & 15, cc = c & 31, ob = rr * 64 + cc * 2; return st * 1024 + (ob ^ (((ob >> 9) & 1) << 5)); }
__host__ __device__ __forceinline__ void stage_rc(int b, int& R, int& C) { const int st = b / 1024, sb = b % 1024, swz = sb ^ (((sb >> 9) & 1) << 5); R = (st >> 1) * 16 + swz / 64; C = (st & 1) * 32 + (swz % 64) / 2; }
__host__ __device__ __forceinline__ int perm32(int rho) { const int n = rho >> 4, i = rho & 15; return 8 * (i >> 2) + 4 * n + (i & 3); }

struct Unit { int pm, pn; };
struct Gemm { const bf16_t* A; const bf16_t* Bt; int M, N, K; };

struct StaticOrder {
    int nM, nN, nwg, G, c;
    __host__ __device__ void init(int M, int N, int G_, int c_) { nM = M / BM; nN = N / BM; nwg = nM * nN; G = G_; c = c_; }
    __host__ __device__ bool next(int i, Unit& u) const {
        const long L = (long)i * G + c; if (L >= nwg) return false;
        int wgid = (int)L; { const int q = nwg / NXCD, r = nwg % NXCD, xcd = wgid % NXCD, off = wgid / NXCD; wgid = (xcd < r ? xcd * (q + 1) : r * (q + 1) + (xcd - r) * q) + off; }
        const int nig = WGM * nN, gid = wgid / nig, fm = gid * WGM, gsz = (nM - fm) < WGM ? (nM - fm) : WGM;
        u.pm = fm + ((wgid % nig) % gsz); u.pn = (wgid % nig) / gsz; return true;
    }
    __device__ __forceinline__ void a_ready(const Unit&) const {}
    __device__ __forceinline__ void done(const Unit&) const {}
};

__device__ __forceinline__ unsigned cvt_pk_bf16(float lo, float hi) { unsigned r; asm volatile("v_cvt_pk_bf16_f32 %0, %1, %2" : "=v"(r) : "v"(lo), "v"(hi)); return r; }
typedef float f32x2 __attribute__((ext_vector_type(2)));
__device__ __forceinline__ void st8(bf16_t* p, f32x4 v0, f32x4 v1) {
    u32x4 w; w.x = cvt_pk_bf16(v0[0], v0[1]); w.y = cvt_pk_bf16(v0[2], v0[3]); w.z = cvt_pk_bf16(v1[0], v1[1]); w.w = cvt_pk_bf16(v1[2], v1[3]);
    *(u32x4*)p = w;
}
__device__ __forceinline__ f32x4 silu4(f32x4 v) { f32x4 o; o[0] = silu_f(v[0]); o[1] = silu_f(v[1]); o[2] = silu_f(v[2]); o[3] = silu_f(v[3]); return o; }

struct EpiRetIn {
    static constexpr bool PERM = true, AFTER_DRAIN = false;
    bf16_t *Q, *K, *V, *SG; const int* pos;
    __device__ __forceinline__ void operator()(const f32x4 (&acc)[2][2][4][2], const Unit& u, int wr, int wc, int fr, int fq) const {
        const int row0 = u.pm * BM + wr * 64 + fr, cl = wc * 32 + 8 * fq;
        if (u.pn < 16) {
            const bool isk = u.pn >= 8; const int head = u.pn & 7;
            bf16_t* base = (isk ? K : Q) + head * 256 + cl;
            f32x4 invf[2];
#pragma unroll
            for (int bj = 0; bj < 2; ++bj) invf[bj] = *(const f32x4*)(INVF256 + 64 * bj + 16 * wc + 4 * fq);
            const float lg = __log2f(1.0f - exp2f(-5.0f - (float)head));
#pragma unroll
            for (int ai = 0; ai < 2; ++ai)
#pragma unroll
                for (int m = 0; m < 4; ++m) {
                    const int row = row0 + ai * HALF + m * 16; const float p = (float)pos[row];
                    const float jj = (float)(wr * 64 + m * 16 + fr + 1);
                    const float dec = isk ? 0.0625f * exp2f(-lg * jj) : exp2f(lg * jj);
#pragma unroll
                    for (int bj = 0; bj < 2; ++bj) { f32x4 o0, o1;
#pragma unroll
                        for (int e = 0; e < 4; ++e) { float s, c; sincos_rr(p * invf[bj][e], s, c);
                            const float x1 = acc[ai][bj][m][0][e], x2 = acc[ai][bj][m][1][e];
                            o0[e] = (x1 * c - x2 * s) * dec; o1[e] = (x2 * c + x1 * s) * dec; }
                        st8(base + (size_t)row * 2048 + bj * HALF, o0, o1); }
                }
        } else {
            const bool isg = u.pn >= 32; bf16_t* base = (isg ? SG + (u.pn - 32) * 256 : V + (u.pn - 16) * 256) + cl;
#pragma unroll
            for (int ai = 0; ai < 2; ++ai)
#pragma unroll
                for (int m = 0; m < 4; ++m) { bf16_t* rowp = base + (size_t)(row0 + ai * HALF + m * 16) * 4096;
#pragma unroll
                    for (int bj = 0; bj < 2; ++bj) { f32x4 v0 = acc[ai][bj][m][0], v1 = acc[ai][bj][m][1];
                        if (isg) { v0 = silu4(v0); v1 = silu4(v1); }
                        st8(rowp + bj * HALF, v0, v1); } }
        }
    }
};
struct EpiResid {
    static constexpr bool PERM = false, AFTER_DRAIN = false;
    const float* base; float* out; const float* gate;
    __device__ __forceinline__ void operator()(const f32x4 (&acc)[2][2][4][2], const Unit& u, int wr, int wc, int fr, int fq) const {
        const int row0 = u.pm * BM + wr * 64 + fr, col0 = u.pn * BM + wc * 32 + 4 * fq;
        const float* gv = gate + (size_t)((u.pm * BM) / SEQ) * 6144 + col0;
        f32x4 g[2][2];
#pragma unroll
        for (int bj = 0; bj < 2; ++bj)
#pragma unroll
            for (int n = 0; n < 2; ++n) g[bj][n] = *(const f32x4*)(gv + bj * HALF + n * 16);
#pragma unroll
        for (int ai = 0; ai < 2; ++ai)
#pragma unroll
            for (int m = 0; m < 4; ++m) { const size_t off = (size_t)(row0 + ai * HALF + m * 16) * 2048 + col0;
#pragma unroll
                for (int bj = 0; bj < 2; ++bj)
#pragma unroll
                    for (int n = 0; n < 2; ++n) { const f32x4 b = *(const f32x4*)(base + off + bj * HALF + n * 16);
                        *(f32x4*)(out + off + bj * HALF + n * 16) = b + g[bj][n] * acc[ai][bj][m][n]; } }
    }
};
struct EpiResidBf {
    static constexpr bool PERM = false, AFTER_DRAIN = false;
    const float* base; bf16_t* out; const float* gate;
    __device__ __forceinline__ void operator()(const f32x4 (&acc)[2][2][4][2], const Unit& u, int wr, int wc, int fr, int fq) const {
        const int row0 = u.pm * BM + wr * 64 + fr, col0 = u.pn * BM + wc * 32 + 4 * fq;
        const float* gv = gate + (size_t)((u.pm * BM) / SEQ) * 6144 + col0;
        f32x4 g[2][2];
#pragma unroll
        for (int bj = 0; bj < 2; ++bj)
#pragma unroll
            for (int n = 0; n < 2; ++n) g[bj][n] = *(const f32x4*)(gv + bj * HALF + n * 16);
#pragma unroll
        for (int ai = 0; ai < 2; ++ai)
#pragma unroll
            for (int m = 0; m < 4; ++m) { const size_t off = (size_t)(row0 + ai * HALF + m * 16) * 2048 + col0;
#pragma unroll
                for (int bj = 0; bj < 2; ++bj)
#pragma unroll
                    for (int n = 0; n < 2; ++n) { const f32x4 b = __builtin_nontemporal_load((const f32x4*)(base + off + bj * HALF + n * 16)); const f32x4 o = b + g[bj][n] * acc[ai][bj][m][n];
                        u32x2 w; w.x = cvt_pk_bf16(o[0], o[1]); w.y = cvt_pk_bf16(o[2], o[3]); *(u32x2*)(out + off + bj * HALF + n * 16) = w; } }
    }
};
struct EpiResidBf2 {
    static constexpr bool PERM = false, AFTER_DRAIN = false;
    const bf16_t* base; bf16_t* out; const float* gate;
    __device__ __forceinline__ void operator()(const f32x4 (&acc)[2][2][4][2], const Unit& u, int wr, int wc, int fr, int fq) const {
        const int row0 = u.pm * BM + wr * 64 + fr, col0 = u.pn * BM + wc * 32 + 4 * fq;
        const float* gv = gate + (size_t)((u.pm * BM) / SEQ) * 6144 + col0;
        f32x4 g[2][2];
#pragma unroll
        for (int bj = 0; bj < 2; ++bj)
#pragma unroll
            for (int n = 0; n < 2; ++n) g[bj][n] = *(const f32x4*)(gv + bj * HALF + n * 16);
#pragma unroll
        for (int ai = 0; ai < 2; ++ai)
#pragma unroll
            for (int m = 0; m < 4; ++m) { const size_t off = (size_t)(row0 + ai * HALF + m * 16) * 2048 + col0;
#pragma unroll
                for (int bj = 0; bj < 2; ++bj)
#pragma unroll
                    for (int n = 0; n < 2; ++n) { const u32x2 bw = *(const u32x2*)(base + off + bj * HALF + n * 16);
                        const f32x4 b = {bflo(bw.x), bfhi(bw.x), bflo(bw.y), bfhi(bw.y)}; const f32x4 o = b + g[bj][n] * acc[ai][bj][m][n];
                        u32x2 w; w.x = cvt_pk_bf16(o[0], o[1]); w.y = cvt_pk_bf16(o[2], o[3]); *(u32x2*)(out + off + bj * HALF + n * 16) = w; } }
    }
};
struct EpiMlaIn {
    static constexpr bool PERM = true, AFTER_DRAIN = false;
    bf16_t *CQ, *CKV, *SG1, *KR; float *ssq_q, *ssq_kv; const int* pos;
    __device__ __forceinline__ void operator()(const f32x4 (&acc)[2][2][4][2], const Unit& u, int wr, int wc, int fr, int fq) const {
        const int row0 = u.pm * BM + wr * 64 + fr, cl = wc * 32 + 8 * fq;
        if (u.pn < 4) {
            bf16_t* base = (u.pn < 2 ? CQ : CKV) + (u.pn & 1) * 256 + cl; float* ssq = u.pn < 2 ? ssq_q : ssq_kv;
#pragma unroll
            for (int ai = 0; ai < 2; ++ai)
#pragma unroll
                for (int m = 0; m < 4; ++m) { const int row = row0 + ai * HALF + m * 16; float s = 0.f;
#pragma unroll
                    for (int bj = 0; bj < 2; ++bj) { const f32x4 v0 = acc[ai][bj][m][0], v1 = acc[ai][bj][m][1];
                        s += (v0[0] * v0[0] + v0[1] * v0[1]) + (v0[2] * v0[2] + v0[3] * v0[3]) + (v1[0] * v1[0] + v1[1] * v1[1]) + (v1[2] * v1[2] + v1[3] * v1[3]);
                        st8(base + (size_t)row * 512 + bj * HALF, v0, v1); }
                    s += __shfl_xor(s, 16); s += __shfl_xor(s, 32);
                    if (fq == 0) atomicAdd(ssq + row, s); }
        } else if (u.pn < 12) {
            bf16_t* base = SG1 + (u.pn - 4) * 256 + cl;
#pragma unroll
            for (int ai = 0; ai < 2; ++ai)
#pragma unroll
                for (int m = 0; m < 4; ++m) { bf16_t* rowp = base + (size_t)(row0 + ai * HALF + m * 16) * 2048;
#pragma unroll
                    for (int bj = 0; bj < 2; ++bj) st8(rowp + bj * HALF, silu4(acc[ai][bj][m][0]), silu4(acc[ai][bj][m][1])); }
        } else if (wc < 2) {
            const f32x4 invf = *(const f32x4*)(INVF64 + 16 * wc + 4 * fq);
#pragma unroll
            for (int ai = 0; ai < 2; ++ai)
#pragma unroll
                for (int m = 0; m < 4; ++m) { const int row = row0 + ai * HALF + m * 16; const float p = (float)pos[row]; f32x4 o0, o1;
#pragma unroll
                    for (int e = 0; e < 4; ++e) { float s, c; sincos_rr(p * invf[e], s, c);
                        const float x1 = acc[ai][0][m][0][e], x2 = acc[ai][0][m][1][e];
                        o0[e] = x1 * c - x2 * s; o1[e] = x2 * c + x1 * s; }
                    st8(KR + (size_t)row * 64 + cl, o0, o1); }
        }
    }
};
struct EpiQUp {
    static constexpr bool PERM = true, AFTER_DRAIN = false;
    bf16_t *QN, *QR; const float* ssq; const int* pos;
    __device__ __forceinline__ void operator()(const f32x4 (&acc)[2][2][4][2], const Unit& u, int wr, int wc, int fr, int fq) const {
        const int row0 = u.pm * BM + wr * 64 + fr, cl = wc * 32 + 8 * fq;
        if (u.pn < 8) {
            bf16_t* base = QN + u.pn * 256 + cl;
#pragma unroll
            for (int ai = 0; ai < 2; ++ai)
#pragma unroll
                for (int m = 0; m < 4; ++m) { const int row = row0 + ai * HALF + m * 16; const float rs = rsqrtf(ssq[row] * (1.0f / 512.0f) + EPS);
#pragma unroll
                    for (int bj = 0; bj < 2; ++bj) st8(base + (size_t)row * 2048 + bj * HALF, acc[ai][bj][m][0] * rs, acc[ai][bj][m][1] * rs); }
        } else {
            const f32x4 invf = *(const f32x4*)(INVF64 + 16 * (wc & 1) + 4 * fq);
#pragma unroll
            for (int ai = 0; ai < 2; ++ai)
#pragma unroll
                for (int m = 0; m < 4; ++m) { const int row = row0 + ai * HALF + m * 16; const float rs = rsqrtf(ssq[row] * (1.0f / 512.0f) + EPS); const float p = (float)pos[row];
                    float sn[4], cs[4];
#pragma unroll
                    for (int e = 0; e < 4; ++e) sincos_rr(p * invf[e], sn[e], cs[e]);
#pragma unroll
                    for (int bj = 0; bj < 2; ++bj) { const int head = 4 * (u.pn - 8) + 2 * bj + (wc >> 1); f32x4 o0, o1;
#pragma unroll
                        for (int e = 0; e < 4; ++e) { const float x1 = acc[ai][bj][m][0][e] * rs, x2 = acc[ai][bj][m][1][e] * rs;
                            o0[e] = x1 * cs[e] - x2 * sn[e]; o1[e] = x2 * cs[e] + x1 * sn[e]; }
                        st8(QR + (size_t)row * 1024 + head * 64 + 32 * (wc & 1) + 8 * fq, o0, o1); } }
        }
    }
};
struct EpiKvUp {
    static constexpr bool PERM = true, AFTER_DRAIN = false;
    bf16_t *KN, *V1; const float* ssq;
    __device__ __forceinline__ void operator()(const f32x4 (&acc)[2][2][4][2], const Unit& u, int wr, int wc, int fr, int fq) const {
        const int row0 = u.pm * BM + wr * 64 + fr, cl = wc * 32 + 8 * fq;
        bf16_t* base = (u.pn < 8 ? KN + u.pn * 256 : V1 + (u.pn - 8) * 256) + cl;
#pragma unroll
        for (int ai = 0; ai < 2; ++ai)
#pragma unroll
            for (int m = 0; m < 4; ++m) { const int row = row0 + ai * HALF + m * 16; const float rs = rsqrtf(ssq[row] * (1.0f / 512.0f) + EPS);
#pragma unroll
                for (int bj = 0; bj < 2; ++bj) st8(base + (size_t)row * 2048 + bj * HALF, acc[ai][bj][m][0] * rs, acc[ai][bj][m][1] * rs); }
    }
};

template <class Epi, class Sched, bool ALIGN_EPI = false, bool SP2 = false>
__device__ __forceinline__ void gemm_phase(PG8_LAS unsigned char* lds, const Gemm g, const Sched& S, const Epi& E) {
    const int tid = threadIdx.x, wid = __builtin_amdgcn_readfirstlane(tid >> 6), lane = tid & 63, wr = wid >> 2, wc = wid & 3, fr = lane & 15, fq = lane >> 4;
    const int K = g.K, nt = K / BK;
    unsigned voffA[2], voffB[2];
#pragma unroll
    for (int i = 0; i < 2; ++i) { int R, C; stage_rc(tid * 16 + i * 8192, R, C); const int Rb = Epi::PERM ? ((R & ~31) + perm32(R & 31)) : R;
        voffA[i] = (unsigned)(R * K + C) * 2u; voffB[i] = (unsigned)(Rb * K + C) * 2u; }
    const size_t kstep = (size_t)(BK * 2);
    const size_t hstep = (size_t)HALF * K * 2;
    const size_t tstep = 2 * hstep;
    const unsigned ldsw = (unsigned)wid * 1024u;
    const int aoff = lds_byte(wr * 64 + fr, fq * 8), boff = lds_byte(wc * 32 + fr, fq * 8);
#define PG8_SA(b, h) (((b) * 2 + (h)) * HTB)
#define PG8_SB(b, h) ((4 + (b) * 2 + (h)) * HTB)
#define PG8_STAGE(bufoff, gbase, voff) do { _Pragma("unroll") for (int _i = 0; _i < 2; ++_i) \
        __builtin_amdgcn_global_load_lds((const unsigned*)((const char*)(gbase) + (voff)[_i]), (PG8_LAS unsigned*)(lds + (bufoff) + ldsw + _i * 8192), 16, 0, 0); } while (0)
#define PG8_LDA(dst, b, h) do { _Pragma("unroll") for (int m = 0; m < 4; ++m) _Pragma("unroll") for (int k = 0; k < 2; ++k) dst[m][k] = *(const PG8_LAS bf16x8*)(lds + PG8_SA(b, h) + aoff + m * 2048 + k * 1024); } while (0)
#define PG8_LDB(dst, b, h) do { _Pragma("unroll") for (int n = 0; n < 2; ++n) _Pragma("unroll") for (int k = 0; k < 2; ++k) dst[n][k] = *(const PG8_LAS bf16x8*)(lds + PG8_SB(b, h) + boff + n * 2048 + k * 1024); } while (0)
#define PG8_MMA(ai, bj, At, Bt) do { __builtin_amdgcn_s_setprio(1); _Pragma("unroll") for (int m = 0; m < 4; ++m) _Pragma("unroll") for (int n = 0; n < 2; ++n) _Pragma("unroll") for (int k = 0; k < 2; ++k) \
        acc[ai][bj][m][n] = __builtin_amdgcn_mfma_f32_16x16x32_bf16(Bt[n][k], At[m][k], acc[ai][bj][m][n], 0, 0, 0); __builtin_amdgcn_s_setprio(0); } while (0)
#define PG8_WAIT_V(n) asm volatile("s_waitcnt vmcnt(" #n ")" ::: "memory")
#define PG8_WAIT_L(n) asm volatile("s_waitcnt lgkmcnt(" #n ")" ::: "memory")
#define PG8_BAR __builtin_amdgcn_s_barrier()
#define PG8_SCHED __builtin_amdgcn_sched_barrier(0)
    Unit cur, nxt; int ui = 0;
    if (!S.next(0, cur)) return;
    f32x4 acc[2][2][4][2];
#pragma unroll
    for (int a = 0; a < 2; ++a)
#pragma unroll
        for (int b = 0; b < 2; ++b)
#pragma unroll
            for (int m = 0; m < 4; ++m)
#pragma unroll
                for (int n = 0; n < 2; ++n) acc[a][b][m][n] = (f32x4){0.f, 0.f, 0.f, 0.f};
    bf16x8 At[4][2], B0[2][2], B1[2][2];
    const char* cA = (const char*)g.A + (size_t)cur.pm * tstep; const char* cB = (const char*)g.Bt + (size_t)cur.pn * tstep;
    S.a_ready(cur);
    if constexpr (SP2) {
        PG8_STAGE(PG8_SB(0, 0), cB, voffB); PG8_STAGE(PG8_SB(0, 1), cB + hstep, voffB); PG8_STAGE(PG8_SA(0, 0), cA, voffA); PG8_STAGE(PG8_SA(0, 1), cA + hstep, voffA);
        if (wr == 1) PG8_BAR;
        PG8_WAIT_V(2); PG8_BAR;
        PG8_STAGE(PG8_SB(1, 0), cB + kstep, voffB); PG8_STAGE(PG8_SA(1, 0), cA + kstep, voffA); PG8_STAGE(PG8_SB(1, 1), cB + hstep + kstep, voffB);
        PG8_WAIT_V(6); PG8_BAR;
    } else {
        PG8_STAGE(PG8_SB(0, 0), cB, voffB); PG8_STAGE(PG8_SA(0, 0), cA, voffA); PG8_STAGE(PG8_SB(0, 1), cB + hstep, voffB); PG8_STAGE(PG8_SA(0, 1), cA + hstep, voffA);
        if (wr == 1) PG8_BAR;
        PG8_WAIT_V(4); PG8_BAR;
        PG8_STAGE(PG8_SB(1, 0), cB + kstep, voffB); PG8_STAGE(PG8_SA(1, 0), cA + kstep, voffA); PG8_STAGE(PG8_SB(1, 1), cB + hstep + kstep, voffB);
        PG8_WAIT_V(6); PG8_BAR;
    }
    for (;;) {
        const bool has_next = S.next(ui + 1, nxt);
        const char* nA = has_next ? (const char*)g.A + (size_t)nxt.pm * tstep : cA; const char* nB = has_next ? (const char*)g.Bt + (size_t)nxt.pn * tstep : cB;
        for (int t = 0; t < nt; t += 2) {
            const bool last = (t == nt - 2);
            const char* a1 = cA + (size_t)(t + 1) * kstep;
            const char* a2 = last ? nA : cA + (size_t)(t + 2) * kstep; const char* b2 = last ? nB : cB + (size_t)(t + 2) * kstep;
            const char* a3 = a2 + kstep; const char* b3 = b2 + kstep;
            if (last && has_next) S.a_ready(nxt);
            if constexpr (SP2) {
            PG8_LDB(B0, 0, 0); PG8_LDB(B1, 0, 1); PG8_SCHED; PG8_LDA(At, 0, 0); PG8_STAGE(PG8_SA(1, 1), a1 + hstep, voffA);
            PG8_WAIT_V(8); PG8_WAIT_L(0); PG8_BAR; PG8_MMA(0, 0, At, B0); PG8_MMA(0, 1, At, B1); PG8_BAR; PG8_SCHED;
            PG8_LDA(At, 0, 1); PG8_STAGE(PG8_SB(0, 0), b2, voffB); PG8_STAGE(PG8_SB(0, 1), b2 + hstep, voffB); PG8_STAGE(PG8_SA(0, 0), a2, voffA);
            PG8_WAIT_V(8); PG8_WAIT_L(0); PG8_BAR; PG8_MMA(1, 0, At, B0); PG8_MMA(1, 1, At, B1); PG8_BAR; PG8_SCHED;
            PG8_LDB(B0, 1, 0); PG8_LDB(B1, 1, 1); PG8_SCHED; PG8_LDA(At, 1, 0); PG8_STAGE(PG8_SA(0, 1), a2 + hstep, voffA);
            PG8_WAIT_V(8); PG8_WAIT_L(0); PG8_BAR; PG8_MMA(0, 0, At, B0); PG8_MMA(0, 1, At, B1); PG8_BAR; PG8_SCHED;
            PG8_LDA(At, 1, 1); PG8_STAGE(PG8_SB(1, 0), b3, voffB); PG8_STAGE(PG8_SB(1, 1), b3 + hstep, voffB); PG8_STAGE(PG8_SA(1, 0), a3, voffA);
            PG8_WAIT_V(8); PG8_WAIT_L(0); PG8_BAR; PG8_MMA(1, 0, At, B0); PG8_MMA(1, 1, At, B1); PG8_BAR; PG8_SCHED;
            } else {
            PG8_LDB(B0, 0, 0); PG8_SCHED; PG8_LDA(At, 0, 0); PG8_STAGE(PG8_SA(1, 1), a1 + hstep, voffA);
            PG8_WAIT_L(8); PG8_BAR; PG8_WAIT_L(0); PG8_MMA(0, 0, At, B0); PG8_BAR; PG8_SCHED;
            PG8_LDB(B1, 0, 1); PG8_STAGE(PG8_SB(0, 0), b2, voffB);
            PG8_BAR; PG8_WAIT_L(0); PG8_MMA(0, 1, At, B1); PG8_BAR;
            PG8_LDA(At, 0, 1); PG8_STAGE(PG8_SA(0, 0), a2, voffA);
            PG8_BAR; PG8_WAIT_L(0); PG8_MMA(1, 0, At, B0); PG8_BAR; PG8_SCHED;
            PG8_STAGE(PG8_SB(0, 1), b2 + hstep, voffB);
            PG8_WAIT_V(6); PG8_BAR; PG8_MMA(1, 1, At, B1); PG8_BAR;
            PG8_LDB(B0, 1, 0); PG8_SCHED; PG8_LDA(At, 1, 0); PG8_STAGE(PG8_SA(0, 1), a2 + hstep, voffA);
            PG8_WAIT_L(8); PG8_BAR; PG8_WAIT_L(0); PG8_MMA(0, 0, At, B0); PG8_BAR; PG8_SCHED;
            PG8_LDB(B1, 1, 1); PG8_STAGE(PG8_SB(1, 0), b3, voffB);
            PG8_BAR; PG8_WAIT_L(0); PG8_MMA(0, 1, At, B1); PG8_BAR;
            PG8_LDA(At, 1, 1); PG8_STAGE(PG8_SA(1, 0), a3, voffA);
            PG8_BAR; PG8_WAIT_L(0); PG8_MMA(1, 0, At, B0); PG8_BAR; PG8_SCHED;
            PG8_STAGE(PG8_SB(1, 1), b3 + hstep, voffB);
            PG8_WAIT_V(6); PG8_BAR; PG8_MMA(1, 1, At, B1); PG8_BAR;
            }
        }
        if constexpr (ALIGN_EPI) { if (wr == 0) PG8_BAR; }
        if constexpr (!Epi::AFTER_DRAIN) { E(acc, cur, wr, wc, fr, fq); S.done(cur); }
        if (!has_next) break;
#pragma unroll
        for (int a = 0; a < 2; ++a)
#pragma unroll
            for (int b = 0; b < 2; ++b)
#pragma unroll
                for (int m = 0; m < 4; ++m)
#pragma unroll
                    for (int n = 0; n < 2; ++n) acc[a][b][m][n] = (f32x4){0.f, 0.f, 0.f, 0.f};
        cur = nxt; cA = nA; cB = nB; ++ui;
        if constexpr (ALIGN_EPI) { if (wr == 1) PG8_BAR; }
    }
    PG8_WAIT_V(0);
    if constexpr (!ALIGN_EPI) { if (wr == 0) PG8_BAR; }
    PG8_BAR;
    if constexpr (Epi::AFTER_DRAIN) { E.fused(acc, cur, wr, wc, fr, fq, lds, wid, lane); S.done(cur); }
#undef PG8_SA
#undef PG8_SB
#undef PG8_STAGE
#undef PG8_LDA
#undef PG8_LDB
#undef PG8_MMA
#undef PG8_WAIT_V
#undef PG8_WAIT_L
#undef PG8_BAR
#undef PG8_SCHED
}
}
namespace att {
constexpr int NW = 8, QBLK = 32, KVBLK = 64, QB = NW * QBLK, DV = 128;
constexpr int SHM_V = KVBLK * 128 * 2, SHM_K = KVBLK * 192 * 2;
constexpr int LDS_QX = 2 * SHM_V + 2 * SHM_K + NW * 64 * 4;
constexpr int LDS_BYTES = LDS_QX + NW * 4096;
constexpr float SCALE = 0.07216878364870322f;
constexpr float THR = 8.f;
#define KSWZ(row, colB) ((row) * 384 + ((colB) ^ (((row) & 7) << 4)))
#define SBAR() __builtin_amdgcn_sched_barrier(0)
__device__ __forceinline__ int v_st(int k, int c) { const int kk = (k & ~0xC) | ((k & 4) << 1) | ((k & 8) >> 1); return ((kk >> 3) * 4 + (c >> 5)) * 512 + ((kk & 7) * 32 + (c & 31)) * 2; }
__device__ __forceinline__ int v_rd_base(int lane) { return ((lane & 3) << 3) | (((lane >> 2) & 3) << 6) | (((lane >> 4) & 1) << 5) | (((lane >> 5) & 1) << 8); }
constexpr int v_rd_off(int d0, int ks, int half) { return d0 * 512 + ks * 4096 + half * 2048; }
__device__ __forceinline__ int crow(int r, int hi) { return (r & 3) + 8 * (r >> 2) + 4 * hi; }
__device__ __forceinline__ void mask_tile(f32x16& p0, f32x16& p1, int dq) {
    const float NEG = -__builtin_inff();
#pragma unroll
    for (int r = 0; r < 16; ++r) { const int c = (r & 3) + 8 * (r >> 2); if (dq - c < 0) p0[r] = NEG; if (dq - c - 32 < 0) p1[r] = NEG; }
}
__device__ __forceinline__ void partialSM(f32x16& p0, f32x16& p1, float& m_reg, float& mn, float& alpha) {
    float pmax = p0[0];
#pragma unroll
    for (int r = 1; r < 16; ++r) pmax = fmaxf(pmax, p0[r]);
#pragma unroll
    for (int r = 0; r < 16; ++r) pmax = fmaxf(pmax, p1[r]);
    { auto rr = __builtin_amdgcn_permlane32_swap(__float_as_uint(pmax), __float_as_uint(pmax), false, false);
      pmax = fmaxf(__uint_as_float(rr[0]), __uint_as_float(rr[1])); }
    constexpr float C2 = 1.4426950408889634f * SCALE;
    if (__builtin_expect(__all((pmax - m_reg) * SCALE <= THR), 1)) { mn = m_reg; alpha = 1.f; }
    else { mn = fmaxf(m_reg, pmax); alpha = __builtin_amdgcn_exp2f((m_reg - mn) * C2); m_reg = mn; }
    const float mnL = -mn * C2;
#pragma unroll
    for (int r = 0; r < 16; ++r) p0[r] = fmaf(p0[r], C2, mnL);
#pragma unroll
    for (int r = 0; r < 16; ++r) p1[r] = fmaf(p1[r], C2, mnL);
#pragma unroll
    for (int r = 0; r < 16; ++r) p0[r] = __builtin_amdgcn_exp2f(p0[r]);
}
#define PK4(P, B_, OUT) do { unsigned a0 = cvtpk(P[B_+0], P[B_+1]), a1 = cvtpk(P[B_+2], P[B_+3]);                          \
        unsigned b0 = cvtpk(P[B_+4], P[B_+5]), b1 = cvtpk(P[B_+6], P[B_+7]);                                             \
        auto r0 = __builtin_amdgcn_permlane32_swap(a0, b0, false, false); auto r1 = __builtin_amdgcn_permlane32_swap(a1, b1, false, false); \
        u32x4 w = {r0[0], r1[0], r0[1], r1[1]}; OUT = *reinterpret_cast<bf16x8*>(&w); } while (0)
__device__ __forceinline__ void finishSM(f32x16& p0, f32x16& p1, float alpha, float& l_reg, bf16x8& pa0, bf16x8& pa1, bf16x8& pa2, bf16x8& pa3) {
#pragma unroll
    for (int r = 0; r < 16; ++r) p1[r] = __builtin_amdgcn_exp2f(p1[r]);
    float ps = 0;
#pragma unroll
    for (int r = 0; r < 16; ++r) ps += p0[r];
#pragma unroll
    for (int r = 0; r < 16; ++r) ps += p1[r];
    { auto rr = __builtin_amdgcn_permlane32_swap(__float_as_uint(ps), __float_as_uint(ps), false, false);
      ps = __uint_as_float(rr[0]) + __uint_as_float(rr[1]); }
    l_reg = l_reg * alpha + ps;
    PK4(p0, 0, pa0); PK4(p0, 8, pa1); PK4(p1, 0, pa2); PK4(p1, 8, pa3);
}
template <int KB>
__device__ __forceinline__ void qkt(f32x16& p0, f32x16& p1, const char* K_lds, int r32, int hi, const bf16x8* qr, const char* qx) {
    p0 = f32x16{}; p1 = f32x16{};
    const char* kb[4];
#pragma unroll
    for (int dd = 0; dd < 4; ++dd) kb[dd] = K_lds + KB * SHM_K + KSWZ(r32, (dd * 16 + hi * 8) * 2);
#pragma unroll
    for (int d0 = 0; d0 < 12; ++d0) { const char* a = kb[d0 & 3] + (d0 >> 2) * 128;
        bf16x8 b0 = *reinterpret_cast<const bf16x8*>(a);
        bf16x8 b1 = *reinterpret_cast<const bf16x8*>(a + 32 * 384);
        const bf16x8 q = d0 < 8 ? qr[d0 & 7] : *reinterpret_cast<const bf16x8*>(qx + (d0 - 8) * 1024);
        p0 = __builtin_amdgcn_mfma_f32_32x32x16_bf16(b0, q, p0, 0, 0, 0);
        p1 = __builtin_amdgcn_mfma_f32_32x32x16_bf16(b1, q, p1, 0, 0, 0); }
}
template <int VB>
__device__ __forceinline__ void pv_tile(f32x16* o, int vb0, bf16x8 pa0, bf16x8 pa1, bf16x8 pa2, bf16x8 pa3) {
#define TRRD(dst, off) asm volatile("ds_read_b64_tr_b16 %0, %1 offset:%2" : "=&v"(dst) : "v"(vb0), "i"(off) : "memory")
#define PV_D2(da, db) do { s16x4 l0, l1, l2, l3, h0, h1, h2, h3, m0, m1, m2, m3, n0, n1, n2, n3; constexpr int b_ = VB * SHM_V + v_rd_off(da, 0, 0), c_ = VB * SHM_V + v_rd_off(db, 0, 0);   \
        TRRD(l0, b_); TRRD(h0, b_ + 2048); TRRD(m0, c_); TRRD(n0, c_ + 2048); TRRD(l1, b_ + 4096); TRRD(h1, b_ + 6144); TRRD(m1, c_ + 4096); TRRD(n1, c_ + 6144);   \
        TRRD(l2, b_ + 8192); TRRD(h2, b_ + 10240); TRRD(m2, c_ + 8192); TRRD(n2, c_ + 10240); TRRD(l3, b_ + 12288); TRRD(h3, b_ + 14336); TRRD(m3, c_ + 12288); TRRD(n3, c_ + 14336);   \
        asm volatile("s_waitcnt lgkmcnt(0)" ::: "memory"); SBAR();     \
        o[da] = __builtin_amdgcn_mfma_f32_32x32x16_bf16(pa0, (bf16x8){l0[0], l0[1], l0[2], l0[3], h0[0], h0[1], h0[2], h0[3]}, o[da], 0, 0, 0);   \
        o[db] = __builtin_amdgcn_mfma_f32_32x32x16_bf16(pa0, (bf16x8){m0[0], m0[1], m0[2], m0[3], n0[0], n0[1], n0[2], n0[3]}, o[db], 0, 0, 0);   \
        o[da] = __builtin_amdgcn_mfma_f32_32x32x16_bf16(pa1, (bf16x8){l1[0], l1[1], l1[2], l1[3], h1[0], h1[1], h1[2], h1[3]}, o[da], 0, 0, 0);   \
        o[db] = __builtin_amdgcn_mfma_f32_32x32x16_bf16(pa1, (bf16x8){m1[0], m1[1], m1[2], m1[3], n1[0], n1[1], n1[2], n1[3]}, o[db], 0, 0, 0);   \
        o[da] = __builtin_amdgcn_mfma_f32_32x32x16_bf16(pa2, (bf16x8){l2[0], l2[1], l2[2], l2[3], h2[0], h2[1], h2[2], h2[3]}, o[da], 0, 0, 0);   \
        o[db] = __builtin_amdgcn_mfma_f32_32x32x16_bf16(pa2, (bf16x8){m2[0], m2[1], m2[2], m2[3], n2[0], n2[1], n2[2], n2[3]}, o[db], 0, 0, 0);   \
        o[da] = __builtin_amdgcn_mfma_f32_32x32x16_bf16(pa3, (bf16x8){l3[0], l3[1], l3[2], l3[3], h3[0], h3[1], h3[2], h3[3]}, o[da], 0, 0, 0);   \
        o[db] = __builtin_amdgcn_mfma_f32_32x32x16_bf16(pa3, (bf16x8){m3[0], m3[1], m3[2], m3[3], n3[0], n3[1], n3[2], n3[3]}, o[db], 0, 0, 0); } while (0)
    PV_D2(0, 1); PV_D2(2, 3);
#undef PV_D2
#undef TRRD
}
struct BlockRef { const bf16_t* QN; const bf16_t* QR; const bf16_t* KN; const bf16_t* KR; const bf16_t* V; const bf16_t* G; bf16_t* O; int P0; };
struct Seam { bf16x8 qr[8]; bf16x8 st_v0, st_v1, st_k0, st_k1, st_k2; };
#define VMW() asm volatile("s_waitcnt vmcnt(0)" ::: "memory")
#define VMWN(n) asm volatile("s_waitcnt vmcnt(%0)" :: "i"(n) : "memory")
#define SLOAD_H(R, k0) do { const bf16_t* Vp_ = (R).V + (size_t)(k0) * 2048; const bf16_t* Kp_ = (R).KN + (size_t)(k0) * 2048; const bf16_t* Rp_ = (R).KR + (size_t)(k0) * 64;  \
                            S.st_v0 = *(const bf16x8*)(Vp_ + voff); S.st_v1 = *(const bf16x8*)(Vp_ + 32 * 2048 + voff);    \
                            S.st_k0 = *(const bf16x8*)(Kp_ + voff); S.st_k1 = *(const bf16x8*)(Kp_ + 32 * 2048 + voff);  \
                            S.st_k2 = *(const bf16x8*)(Rp_ + roff); } while (0)
#define SWRITE_HK(bf) do { *(bf16x8*)(K_lds + (bf) * SHM_K + kws) = S.st_k0; *(bf16x8*)(K_lds + (bf) * SHM_K + kws + 32 * 384) = S.st_k1; *(bf16x8*)(K_lds + (bf) * SHM_K + kws2) = S.st_k2; } while (0)
#define SWRITE_HV(bf) do { *(bf16x8*)(V_lds + (bf) * SHM_V + vst0) = S.st_v0; *(bf16x8*)(V_lds + (bf) * SHM_V + vst1) = S.st_v1; } while (0)
#define SWRITE_H(bf) do { SWRITE_HV(bf); SWRITE_HK(bf); } while (0)
#define QLOAD(R) do { _Pragma("unroll") for (int d0 = 0; d0 < 8; ++d0) S.qr[d0] = *(const bf16x8*)((R).QN + d0 * 16 + qoff); } while (0)
__device__ __forceinline__ void attn_prime(const BlockRef& cur, char* lds, Seam& S) {
    const int tid = threadIdx.x, wid = __builtin_amdgcn_readfirstlane(tid >> 6), lane = tid & 63, r32 = lane & 31, hi = lane >> 5;
    const int sr = tid >> 4, sc = (tid & 15) * 8, rr = tid >> 3, rc = (tid & 7) * 8, kws = KSWZ(sr, sc * 2), kws2 = KSWZ(rr, (128 + rc) * 2); char* K_lds = lds;
    const unsigned voff = (unsigned)(sr * 2048 + sc), roff = (unsigned)(rr * 64 + rc), qoff = (unsigned)((wid * QBLK + r32) * 2048 + hi * 8);
    QLOAD(cur);
    SLOAD_H(cur, 0); VMW(); SWRITE_HK(0);
    __syncthreads();
}
__device__ __forceinline__ void attn_block(const BlockRef& cur, const BlockRef& nxt, char* lds, Seam& S) {
    const int tid = threadIdx.x, wid = __builtin_amdgcn_readfirstlane(tid >> 6), lane = tid & 63, r32 = lane & 31, hi = lane >> 5;
    const int NT = (cur.P0 + QB) / KVBLK;
    const int qlo = cur.P0 + wid * QBLK, qm = qlo + r32 - 4 * hi;
    char* K_lds = lds; char* V_lds = lds + 2 * SHM_K;
    float* ws = (float*)(lds + 2 * SHM_V + 2 * SHM_K) + wid * 64; float* li_l = ws, * al_l = ws + 32;
    char* qx = lds + LDS_QX + wid * 4096 + lane * 16;
    { bf16x8 t4[4];
#pragma unroll
      for (int d0 = 0; d0 < 4; ++d0) t4[d0] = *(const bf16x8*)(cur.QR + d0 * 16 + (unsigned)((wid * QBLK + r32) * 1024 + hi * 8));
#pragma unroll
      for (int d0 = 0; d0 < 4; ++d0) *(bf16x8*)(qx + d0 * 1024) = t4[d0]; }
    float m_reg = -1e30f, l_reg = 0; f32x16 o[4] = {};
    const int sr = tid >> 4, sc = (tid & 15) * 8, rr = tid >> 3, rc = (tid & 7) * 8;
    const unsigned voff = (unsigned)(sr * 2048 + sc), roff = (unsigned)(rr * 64 + rc), qoff = (unsigned)((wid * QBLK + r32) * 2048 + hi * 8);
    const int vst0 = v_st(sr, sc), vst1 = v_st(32 + sr, sc), kws = KSWZ(sr, sc * 2), kws2 = KSWZ(rr, (128 + rc) * 2);
    const int vb0 = (int)(uintptr_t)V_lds + v_rd_base(lane);
#define RESC(a) do { if (__any((a) < 1.f)) { if (hi == 0) al_l[r32] = (a); asm volatile("s_waitcnt lgkmcnt(0)" ::: "memory");              \
                     _Pragma("unroll") for (int d_ = 0; d_ < 4; ++d_) _Pragma("unroll") for (int r = 0; r < 16; ++r) o[d_][r] *= al_l[crow(r, hi)]; } } while (0)
#define KBASE(t) ((t) * KVBLK)
#define MASKT(P0_, P1_, t) do { const int kb_ = KBASE(t); if (kb_ + KVBLK - 1 > qlo) mask_tile(P0_, P1_, qm - kb_); } while (0)
#define SEAM_K0() do { VMWN(8); SWRITE_HK(0); SBAR(); } while (0)
    f32x16 pA0, pA1, pB0, pB1; float mnA, mnB, alA, alB; bf16x8 pa0, pa1, pa2, pa3;
    SWRITE_HV(0); SBAR();
    if (NT > 1) SLOAD_H(cur, KBASE(1));
    SBAR(); qkt<0>(pA0, pA1, K_lds, r32, hi, S.qr, qx);
    MASKT(pA0, pA1, 0); partialSM(pA0, pA1, m_reg, mnA, alA);
    if (NT > 1) { VMW(); SWRITE_H(1); }
    __syncthreads();
#define HALF_STEP(PX0, PX1, mnX, alX, PY0, PY1, alY, t, KB, VB, SB) do {                                                      \
        SBAR(); qkt<KB>(PX0, PX1, K_lds, r32, hi, S.qr, qx);                                                                      \
        finishSM(PY0, PY1, alY, l_reg, pa0, pa1, pa2, pa3); SBAR();                                                           \
        if ((t) + 1 < NT) { SLOAD_H(cur, KBASE((t) + 1)); SBAR(); }                                                           \
        pv_tile<VB>(o, vb0, pa0, pa1, pa2, pa3); MASKT(PX0, PX1, (t)); partialSM(PX0, PX1, m_reg, mnX, alX);                  \
        __syncthreads();                                                                                                      \
        if ((t) + 1 < NT) { VMW(); SWRITE_H(SB); }                                                                            \
        RESC(alX); __syncthreads(); } while (0)
    for (int t = 1; t + 1 < NT; t += 2) {
        HALF_STEP(pB0, pB1, mnB, alB, pA0, pA1, alA, t, 1, 0, 0);
        HALF_STEP(pA0, pA1, mnA, alA, pB0, pB1, alB, t + 1, 0, 1, 1);
    }
    SBAR(); qkt<1>(pB0, pB1, K_lds, r32, hi, S.qr, qx); SBAR();
    finishSM(pA0, pA1, alA, l_reg, pa0, pa1, pa2, pa3); SBAR();
    pv_tile<0>(o, vb0, pa0, pa1, pa2, pa3);
    SBAR(); SLOAD_H(nxt, 0); SBAR();
    MASKT(pB0, pB1, NT - 1); partialSM(pB0, pB1, m_reg, mnB, alB); __syncthreads(); RESC(alB);
    finishSM(pB0, pB1, alB, l_reg, pa0, pa1, pa2, pa3); SBAR(); pv_tile<1>(o, vb0, pa0, pa1, pa2, pa3);
    SBAR(); QLOAD(nxt); SBAR();
    SEAM_K0();
    if (hi == 0) li_l[r32] = l_reg; asm volatile("s_waitcnt lgkmcnt(0)" ::: "memory");
    float rli[16];
#pragma unroll
    for (int r = 0; r < 16; ++r) rli[r] = __builtin_amdgcn_rcpf(li_l[crow(r, hi)]);
    const int odd = r32 & 1;
    unsigned ob0 = (unsigned)((wid * QBLK + 4 * hi + odd) * 2048 + (r32 & ~1)) * 2u; asm volatile("" : "+v"(ob0));
    unsigned gpv[8][4];
#pragma unroll
    for (int r = 0; r < 16; r += 2)
#pragma unroll
        for (int d0 = 0; d0 < 4; ++d0) gpv[r >> 1][d0] = *(const unsigned*)((const char*)cur.G + (ob0 + (unsigned)(((r & 3) + 8 * (r >> 2)) * 4096 + d0 * 64)));
#pragma unroll
    for (int r = 0; r < 16; r += 2) {
#pragma unroll
        for (int d0 = 0; d0 < 4; ++d0) { const float a = o[d0][r] * rli[r], b = o[d0][r + 1] * rli[r + 1];
            const float rv = __shfl_xor(odd ? a : b, 1);
            const unsigned bo = ob0 + (unsigned)(((r & 3) + 8 * (r >> 2)) * 4096 + d0 * 64);
            const unsigned gp = gpv[r >> 1][d0];
            const float lo = (odd ? rv : a) * bflo(gp), hv = (odd ? b : rv) * bfhi(gp);
            *(unsigned*)((char*)cur.O + bo) = cvtpk(lo, hv); } }
    __syncthreads();
#undef RESC
#undef KBASE
#undef MASKT
#undef SEAM_K0
#undef HALF_STEP
}
#undef VMW
#undef VMWN
#undef SLOAD_H
#undef SWRITE_HK
#undef SWRITE_HV
#undef SWRITE_H
#undef QLOAD
struct Tensors { const bf16_t* QN; const bf16_t* QR; const bf16_t* KN; const bf16_t* KR; const bf16_t* V; const bf16_t* G; bf16_t* O; };
__device__ __forceinline__ BlockRef mkref(const Tensors& Tn, int bh, int qb) {
    const int b = bh >> 4, h = bh & 15; const size_t r0 = (size_t)b * SEQ, rq = r0 + (size_t)qb * QB; BlockRef r;
    r.QN = Tn.QN + rq * 2048 + h * 128; r.QR = Tn.QR + rq * 1024 + h * 64; r.KN = Tn.KN + r0 * 2048 + h * 128; r.KR = Tn.KR + r0 * 64; r.V = Tn.V + r0 * 2048 + h * 128;
    r.G = Tn.G + rq * 2048 + h * 128; r.O = Tn.O + rq * 2048 + h * 128; r.P0 = qb * QB; return r;
}
__device__ __forceinline__ void attn_phase(char* lds, const Tensors& Tn) {
    constexpr int NQB = SEQ / QB, NX = NQB / 2, TOTAL = NX * BATCH * MLA_H;
    const int stride = gridDim.x; int L = (stride % 8 == 0) ? (int)(blockIdx.x % 8) * (stride / 8) + (int)(blockIdx.x / 8) : (int)blockIdx.x; if (L >= TOTAL) return;
    int pass = 0; int bh = L / NX, y = L % NX;
    BlockRef cur = mkref(Tn, bh, y);
    Seam S;
    attn_prime(cur, lds, S);
    for (;;) {
        const bool more_pass = pass == 0, more_item = L + stride < TOTAL, last = !more_pass && !more_item;
        int passn = pass + 1, Ln = L, bhn = bh, yn = y;
        if (!more_pass) { passn = 0; Ln = more_item ? L + stride : L; bhn = Ln / NX; yn = Ln % NX; }
        const BlockRef nxt = last ? cur : mkref(Tn, bhn, passn ? NQB - 1 - yn : yn);
        attn_block(cur, nxt, lds, S);
        if (last) break;
        cur = nxt; pass = passn; L = Ln; bh = bhn; y = yn;
    }
}
#undef KSWZ
#undef SBAR
#undef PK4
}

namespace ret {
constexpr int PK = 544, PKP = 528, PV = 144, PS = 528;
constexpr int OFF_K = 0, OFF_V = 128 * PK, OFF_S = OFF_V + 128 * PV, LDS_BYTES = OFF_S + 64 * PS;
__device__ __forceinline__ int crow(int r, int hi) { return (r & 3) + 8 * (r >> 2) + 4 * hi; }
typedef short v4i16_t __attribute__((ext_vector_type(4)));
__device__ __forceinline__ s16x4 trd(LAS const char* p) { return __builtin_bit_cast(s16x4, __builtin_amdgcn_ds_read_tr16_b64_v4i16((LAS v4i16_t*)p)); }
__device__ __forceinline__ bf16x8 tr8(LAS const char* p, int pitch) { const s16x4 a = trd(p), b = trd(p + 4 * pitch); return (bf16x8){a[0], a[1], a[2], a[3], b[0], b[1], b[2], b[3]}; }
#define PK4R(P, B_, OUT) do { unsigned a0 = cvtpk(P[B_+0], P[B_+1]), a1 = cvtpk(P[B_+2], P[B_+3]);                          \
        unsigned b0 = cvtpk(P[B_+4], P[B_+5]), b1 = cvtpk(P[B_+6], P[B_+7]);                                             \
        auto r0 = __builtin_amdgcn_permlane32_swap(a0, b0, false, false); auto r1 = __builtin_amdgcn_permlane32_swap(a1, b1, false, false); \
        u32x4 w = {r0[0], r1[0], r0[1], r1[1]}; OUT = *reinterpret_cast<bf16x8*>(&w); } while (0)
__device__ __forceinline__ void retp_phase(LAS char* lds, const bf16_t* Qg, bf16_t* Kg, bf16x8* Pf) {
    const int tid = threadIdx.x, w = __builtin_amdgcn_readfirstlane(tid >> 6), lane = tid & 63, r32 = lane & 31, hi = lane >> 5;
    const int nb = w & 3, half = w >> 2;
    LAS char* Ks = lds + OFF_K;
    const int trKP = (8 * (lane >> 5) + ((lane & 15) >> 2)) * PKP + (16 * ((lane >> 4) & 1) + 4 * (lane & 3)) * 2;
    LAS char* Qs = lds + OFF_K + 128 * PKP;
    bf16x8 stk[8], stq[8];
    int it = blockIdx.x;
    if (it < 2048) {
        const bf16_t* kb_ = Kg + ((size_t)(it >> 6) / 8 * SEQ + (size_t)(it & 63) * 128) * 2048 + ((it >> 6) & 7) * 256;
#pragma unroll
        for (int i = 0; i < 8; ++i) stk[i] = *(const bf16x8*)(kb_ + (size_t)((tid >> 5) + 16 * i) * 2048 + (tid & 31) * 8);
        const bf16_t* qf_ = Qg + (kb_ - Kg);
#pragma unroll
        for (int i = 0; i < 8; ++i) stq[i] = *(const bf16x8*)(qf_ + (size_t)((tid >> 5) + 16 * i) * 2048 + (tid & 31) * 8);
    }
    for (; it < 2048; it += gridDim.x) {
        const int bh = it >> 6, ci = it & 63, b = bh >> 3, h = bh & 7;
#pragma unroll
        for (int i = 0; i < 8; ++i) { *(LAS bf16x8*)(Ks + ((tid >> 5) + 16 * i) * PKP + (tid & 31) * 16) = stk[i]; *(LAS bf16x8*)(Qs + ((tid >> 5) + 16 * i) * PKP + (tid & 31) * 16) = stq[i]; }
        __syncthreads();
        bf16x8 qr[16];
#pragma unroll
        for (int s = 0; s < 16; ++s) qr[s] = *(LAS const bf16x8*)(Qs + (32 * nb + r32) * PKP + 16 * hi + 32 * s);
        { const int itn = it + (int)gridDim.x < 2048 ? it + (int)gridDim.x : it;
          const bf16_t* kn_ = Kg + ((size_t)(itn >> 6) / 8 * SEQ + (size_t)(itn & 63) * 128) * 2048 + ((itn >> 6) & 7) * 256;
#pragma unroll
          for (int i = 0; i < 8; ++i) stk[i] = *(const bf16x8*)(kn_ + (size_t)((tid >> 5) + 16 * i) * 2048 + (tid & 31) * 8);
          const bf16_t* qn_ = Qg + (kn_ - Kg);
#pragma unroll
          for (int i = 0; i < 8; ++i) stq[i] = *(const bf16x8*)(qn_ + (size_t)((tid >> 5) + 16 * i) * 2048 + (tid & 31) * 8); }
        for (int mt = half; mt <= nb; mt += 2) {
            f32x16 p = {};
            LAS const char* kp = Ks + (32 * mt + r32) * PKP + 16 * hi;
#pragma unroll
            for (int s = 0; s < 16; ++s) { const bf16x8 afr = *(LAS const bf16x8*)(kp + 32 * s); p = __builtin_amdgcn_mfma_f32_32x32x16_bf16(afr, qr[s], p, 0, 0, 0); }
            if (mt == nb) {
#pragma unroll
                for (int r = 0; r < 16; ++r) if (crow(r, hi) > r32) p[r] = 0.f;
            }
            bf16x8 pa0, pa1; PK4R(p, 0, pa0); PK4R(p, 8, pa1);
            bf16x8* dst = Pf + ((size_t)(it * 10 + nb * (nb + 1) / 2 + mt) * 2) * 64 + lane;
            dst[0] = pa0; dst[64] = pa1;
        }
        __builtin_amdgcn_sched_barrier(0);
        { bf16_t* kw_ = Kg + ((size_t)b * SEQ + (size_t)ci * 128) * 2048 + h * 256 + (size_t)(16 * w + hi) * 2048 + r32 * 8;
#pragma unroll
          for (int ks = 0; ks < 8; ++ks) { const bf16x8 af = tr8(Ks + trKP + (32 * w) * 2 + 16 * ks * PKP, PKP); *(bf16x8*)(kw_ + (size_t)ks * 2 * 2048) = af; } }
        __syncthreads();
    }
}
constexpr int PQ = 528, SOFF_V = 0, SOFF_S = 128 * PV, SOFF_Q = SOFF_S + 64 * PS, SCAN_LDS = SOFF_Q + 128 * PQ;
__device__ __forceinline__ void ret_phase(LAS char* lds, const bf16_t* Qg, const bf16_t* Kg, const bf16_t* Vg, bf16_t* Og, const bf16x8* Pf) {
    const int tid = threadIdx.x, w = __builtin_amdgcn_readfirstlane(tid >> 6), lane = tid & 63, r32 = lane & 31, hi = lane >> 5;
    const int nb = (w < 4) ? w : 7 - w, vh = w >> 2;
    const int trh = lane >> 5, trblk = (lane >> 4) & 1, trq = (lane & 15) >> 2, trp = lane & 3;
    const int trV = (8 * trh + trq) * PV + (16 * trblk + 4 * trp) * 2;
    for (int it = blockIdx.x; it < 256; it += gridDim.x) {
        const int bh = (it & 7) * 4 + (it >> 6), vs = (it >> 3) & 7, b = bh >> 3, h = bh & 7;
        const size_t rowbase = (size_t)b * SEQ;
        const bf16_t* qb_ = Qg + rowbase * 2048 + h * 256; const unsigned qo = (unsigned)((tid >> 5) * 2048 + (tid & 31) * 8);
        const bf16_t* kf_ = Kg + rowbase * 2048 + h * 256; const unsigned ko = (unsigned)((16 * w + hi) * 2048 + r32 * 8);
        const bf16_t* vb_ = Vg + rowbase * 4096 + h * 512 + vs * 64; bf16_t* ob_ = Og + rowbase * 4096 + h * 512 + vs * 64;
        const unsigned vo0 = (unsigned)((tid >> 3) * 4096 + (tid & 7) * 8);
        const bf16x8* pfb = Pf + ((size_t)(bh * 64) * 10 + nb * (nb + 1) / 2) * 128; const unsigned po = (unsigned)lane;
        const float g128 = exp2f(128.0f * __log2f(1.0f - exp2f(-5.0f - (float)h)));
        f32x16 U0 = {}, U1 = {};
        bf16x8 stq[8], ka[8], stv[2], pf[8];
        stv[0] = *(const bf16x8*)(vb_ + vo0); stv[1] = *(const bf16x8*)(vb_ + 64 * 4096 + vo0);
#pragma unroll
        for (int i = 0; i < 8; ++i) stq[i] = *(const bf16x8*)(qb_ + i * 16 * 2048 + qo);
#pragma unroll
        for (int mt = 0; mt < 4; ++mt) { const int mc = mt <= nb ? mt : nb; pf[2 * mt] = (pfb + mc * 128)[po]; pf[2 * mt + 1] = (pfb + mc * 128 + 64)[po]; }
#pragma unroll
        for (int ks = 0; ks < 8; ++ks) ka[ks] = *(const bf16x8*)(kf_ + ks * 2 * 2048 + ko);
#pragma unroll
        for (int i = 0; i < 2; ++i) { const int c = tid + 512 * i; *(LAS bf16x8*)(lds + SOFF_V + (c >> 3) * PV + (c & 7) * 16) = stv[i]; }
#pragma unroll
        for (int g = 0; g < 4; ++g) { const u32x2 z = {0u, 0u};
            *(LAS u32x2*)(lds + SOFF_S + r32 * PS + (32 * w + 8 * g + 4 * hi) * 2) = z; *(LAS u32x2*)(lds + SOFF_S + (32 + r32) * PS + (32 * w + 8 * g + 4 * hi) * 2) = z; }
#pragma unroll
        for (int i = 0; i < 8; ++i) *(LAS bf16x8*)(lds + SOFF_Q + ((tid >> 5) + 16 * i) * PQ + (tid & 31) * 16) = stq[i];
        __syncthreads();
        LAS char* Vs = lds + SOFF_V; LAS char* Ss = lds + SOFF_S; LAS char* Qs = lds + SOFF_Q;
        for (int ci = 0; ci < 64; ++ci) {
            const size_t cn = ci + 1 < 64 ? ci + 1 : 63;
            { const bf16_t* vn_ = vb_ + cn * (128 * 4096); stv[0] = *(const bf16x8*)(vn_ + vo0); stv[1] = *(const bf16x8*)(vn_ + 64 * 4096 + vo0); }
#pragma unroll
            for (int i = 0; i < 8; ++i) stq[i] = *(const bf16x8*)(qb_ + cn * (128 * 2048) + i * 16 * 2048 + qo);
            f32x16 o = {}, o2 = {};
            { LAS const char* sp = Ss + (32 * vh + r32) * PS + 16 * hi; LAS const char* qp = Qs + (32 * nb + r32) * PQ + 16 * hi;
#pragma unroll
              for (int s = 0; s < 16; s += 2) { const bf16x8 afr = *(LAS const bf16x8*)(qp + 32 * s), bfr = *(LAS const bf16x8*)(sp + 32 * s), afr2 = *(LAS const bf16x8*)(qp + 32 * s + 32), bfr2 = *(LAS const bf16x8*)(sp + 32 * s + 32);
                  o = __builtin_amdgcn_mfma_f32_32x32x16_bf16(afr, bfr, o, 0, 0, 0); o2 = __builtin_amdgcn_mfma_f32_32x32x16_bf16(afr2, bfr2, o2, 0, 0, 0); }
#pragma unroll
              for (int r = 0; r < 16; ++r) o[r] += o2[r]; }
#pragma unroll
            for (int mt = 0; mt < 4; ++mt) if (mt <= nb) {
                LAS const char* vp = Vs + trV + (32 * mt) * PV + (32 * vh) * 2;
                const bf16x8 v0 = tr8(vp, PV), v1 = tr8(vp + 16 * PV, PV);
                o = __builtin_amdgcn_mfma_f32_32x32x16_bf16(pf[2 * mt], v0, o, 0, 0, 0);
                o = __builtin_amdgcn_mfma_f32_32x32x16_bf16(pf[2 * mt + 1], v1, o, 0, 0, 0);
            }
            { const int odd = r32 & 1; bf16_t* oc = ob_ + (size_t)ci * (128 * 4096);
              const unsigned oo = (unsigned)((32 * nb + 4 * hi + odd) * 4096 + 32 * vh + (r32 & ~1));
#pragma unroll
              for (int r = 0; r < 16; r += 2) { const float a = o[r], b = o[r + 1]; const float rv = __shfl_xor(odd ? a : b, 1);
                  const unsigned wv = cvtpk(odd ? rv : a, odd ? b : rv);
                  *(unsigned*)(oc + ((r & 3) + 8 * (r >> 2)) * 4096 + oo) = wv; } }
            { LAS const char* va = Vs + trV;
#pragma unroll
              for (int ks = 0; ks < 8; ++ks) {
                  const bf16x8 b0 = tr8(va + 16 * ks * PV, PV), b1 = tr8(va + 16 * ks * PV + 64, PV);
                  U0 = __builtin_amdgcn_mfma_f32_32x32x16_bf16(ka[ks], b0, U0, 0, 0, 0);
                  U1 = __builtin_amdgcn_mfma_f32_32x32x16_bf16(ka[ks], b1, U1, 0, 0, 0); } }
#pragma unroll
            for (int ks = 0; ks < 8; ++ks) ka[ks] = *(const bf16x8*)(kf_ + cn * (128 * 2048) + ks * 2 * 2048 + ko);
#pragma unroll
            for (int mt = 0; mt < 4; ++mt) { const int mc = mt <= nb ? mt : nb; pf[2 * mt] = (pfb + cn * 1280 + mc * 128)[po]; pf[2 * mt + 1] = (pfb + cn * 1280 + mc * 128 + 64)[po]; }
#pragma unroll
            for (int r = 0; r < 16; ++r) { U0[r] *= g128; U1[r] *= g128; }
            __syncthreads();
#pragma unroll
            for (int i = 0; i < 2; ++i) { const int c = tid + 512 * i; *(LAS bf16x8*)(Vs + (c >> 3) * PV + (c & 7) * 16) = stv[i]; }
#pragma unroll
            for (int i = 0; i < 8; ++i) *(LAS bf16x8*)(Qs + ((tid >> 5) + 16 * i) * PQ + (tid & 31) * 16) = stq[i];
#pragma unroll
            for (int g = 0; g < 4; ++g) {
                u32x2 a; a.x = cvtpk(U0[4 * g], U0[4 * g + 1]); a.y = cvtpk(U0[4 * g + 2], U0[4 * g + 3]);
                *(LAS u32x2*)(Ss + r32 * PS + (32 * w + 8 * g + 4 * hi) * 2) = a;
                u32x2 c; c.x = cvtpk(U1[4 * g], U1[4 * g + 1]); c.y = cvtpk(U1[4 * g + 2], U1[4 * g + 3]);
                *(LAS u32x2*)(Ss + (32 + r32) * PS + (32 * w + 8 * g + 4 * hi) * 2) = c;
            }
            __syncthreads();
        }
    }
}
#undef PK4R
}

constexpr int NWAVES = 8, NTHREADS = 512, LDS_BYTES = 147456;
struct Args { const float* x; const float* c; const int* pos; const float* ada_w; const float* ada_b; const float* norm_g; const float* ret_w_in; const float* ret_gn_g; const float* ret_w_out;
              const float* mla_w_in; const float* mla_qn_g; const float* mla_w_uq; const float* mla_kvn_g; const float* mla_w_ukv; const float* mla_w_out; const float* final_g;
              float* out; unsigned char* ws; int ph_lo, ph_hi, li, pad; };

__device__ __forceinline__ int rp8(int p) { return 4 * (p >> 3) + (p & 3); }
__device__ __forceinline__ int srccol(int map, int n) {
    if (map == 1) { if (n >= 4096) return n; const int p = n & 255; return (n & ~255) + rp8(p) + 128 * ((p >> 2) & 1); }
    if (map == 2) { if (n < 1024) return n; if (n < 3072) return n + 64; if (n < 3136) { const int p = n - 3072; return 1024 + rp8(p) + 32 * ((p >> 2) & 1); } return -1; }
    if (map == 3) { if (n < 2048) return (n >> 7) * 192 + (n & 127); const int m = n - 2048, p = m & 63; return (m >> 6) * 192 + 128 + rp8(p) + 32 * ((p >> 2) & 1); }
    if (map == 4) { if (n < 2048) return (n >> 7) * 256 + (n & 127); const int m = n - 2048; return (m >> 7) * 256 + 128 + (m & 127); }
    return n;
}
__device__ __forceinline__ void transpose_item(const float* W, int K, int Nsrc, bf16_t* WT, int map, const float* kscale, LAS float* scr, int kb, int nb, int lane) {
    const int k0 = 64 * kb, n0 = 32 * nb, sc = srccol(map, n0 + (lane & 31));
    float tv[32]; const int scc = sc >= 0 ? sc : 0;
#pragma unroll
    for (int i = 0; i < 32; ++i) tv[i] = W[(size_t)(k0 + 2 * i + (lane >> 5)) * Nsrc + scc];
#pragma unroll
    for (int i = 0; i < 32; ++i) { const int kk = 2 * i + (lane >> 5); float v = sc >= 0 ? tv[i] : 0.f; if (kscale) v *= kscale[k0 + kk]; scr[kk * 33 + (lane & 31)] = v; }
    asm volatile("s_waitcnt lgkmcnt(0)" ::: "memory");
    const int c = lane & 7;
#pragma unroll
    for (int j = 0; j < 4; ++j) { const int n = (lane >> 3) + 8 * j; const LAS float* s = scr + (8 * c) * 33 + n;
        u32x4 o; o.x = cvtpk(s[0 * 33], s[1 * 33]); o.y = cvtpk(s[2 * 33], s[3 * 33]); o.z = cvtpk(s[4 * 33], s[5 * 33]); o.w = cvtpk(s[6 * 33], s[7 * 33]);
        *(u32x4*)(WT + (size_t)(n0 + n) * K + k0 + 8 * c) = o; }
    asm volatile("s_waitcnt lgkmcnt(0)" ::: "memory");
}
__device__ __forceinline__ void prologue(const Args& a, LAS unsigned char* lds) {
    const int tid = threadIdx.x, lane = tid & 63, wave = __builtin_amdgcn_readfirstlane(tid >> 6), G = gridDim.x;
    unsigned char* ws = a.ws;
    float* mod = (float*)(ws + WS_CTL + CTL_MOD); float* ssq = (float*)(ws + WS_CTL + CTL_SSQQ);
    for (int i = blockIdx.x * NTHREADS + tid; i < 2 * T; i += G * NTHREADS) ssq[i] = 0.f;
    LAS float* ca = (LAS float*)lds; LAS float* red = (LAS float*)(lds + 32768);
    if (blockIdx.x < 192) {
        for (int i = tid; i < 4 * DM; i += NTHREADS) ca[i] = silu_f(a.c[i]);
        __syncthreads();
        for (int item = blockIdx.x; item < 192; item += G) {
            const int l = item / 96, cb = item % 96, c4 = tid & 15, kp = tid >> 4, col = cb * 64 + c4 * 4;
            const float* W = a.ada_w + (size_t)l * DM * 6144 + col;
            f32x4 acc0 = {0.f, 0.f, 0.f, 0.f}, acc1 = acc0, acc2 = acc0, acc3 = acc0;
#pragma unroll 8
            for (int k = kp * 64; k < kp * 64 + 64; ++k) { const f32x4 wv = *(const f32x4*)(W + (size_t)k * 6144); acc0 += wv * ca[k]; acc1 += wv * ca[2048 + k]; acc2 += wv * ca[4096 + k]; acc3 += wv * ca[6144 + k]; }
            *(LAS f32x4*)(red + ((kp * 4 + 0) * 64 + c4 * 4)) = acc0; *(LAS f32x4*)(red + ((kp * 4 + 1) * 64 + c4 * 4)) = acc1;
            *(LAS f32x4*)(red + ((kp * 4 + 2) * 64 + c4 * 4)) = acc2; *(LAS f32x4*)(red + ((kp * 4 + 3) * 64 + c4 * 4)) = acc3;
            __syncthreads();
            if (tid < 256) { const int b = tid >> 6, cl = tid & 63; float s = a.ada_b[l * 6144 + cb * 64 + cl];
#pragma unroll 8
                for (int q = 0; q < 32; ++q) s += red[(q * 4 + b) * 64 + cl];
                mod[(size_t)(l * 4 + b) * 6144 + cb * 64 + cl] = s; }
            __syncthreads();
        }
    }
    LAS float* scr = (LAS float*)(lds + 65536 + wave * 8704);
    const int gw = blockIdx.x * NWAVES + wave, NGW = G * NWAVES;
    constexpr int I0 = 32 * 384, I1 = 64 * 64, I2 = 32 * 104, I3 = 8 * 96, I4 = 8 * 128, I5 = 32 * 64, NIT = I0 + I1 + I2 + I3 + I4 + I5;
    for (int it = gw; it < NIT; it += NGW) {
        int r = it;
        if (r < I0) { transpose_item(a.ret_w_in, 2048, RET_IN, (bf16_t*)(ws + WS_WRIN), 1, nullptr, scr, r / 384, r % 384, lane); continue; } r -= I0;
        if (r < I1) { transpose_item(a.ret_w_out, 4096, 2048, (bf16_t*)(ws + WS_WROUT), 0, a.ret_gn_g, scr, r / 64, r % 64, lane); continue; } r -= I1;
        if (r < I2) { transpose_item(a.mla_w_in, 2048, MLA_IN, (bf16_t*)(ws + WS_WMIN), 2, nullptr, scr, r / 104, r % 104, lane); continue; } r -= I2;
        if (r < I3) { transpose_item(a.mla_w_uq, 512, 3072, (bf16_t*)(ws + WS_WUQ), 3, a.mla_qn_g, scr, r / 96, r % 96, lane); continue; } r -= I3;
        if (r < I4) { transpose_item(a.mla_w_ukv, 512, 4096, (bf16_t*)(ws + WS_WUKV), 4, a.mla_kvn_g, scr, r / 128, r % 128, lane); continue; } r -= I4;
        transpose_item(a.mla_w_out, 2048, 2048, (bf16_t*)(ws + WS_WMOUT), 0, nullptr, scr, r / 64, r % 64, lane);
    }
}
__device__ __forceinline__ void norm_mod_pass(const float* xin, const float* g, const float* modl, bf16_t* H) {
    int tid = threadIdx.x; asm volatile("" : "+v"(tid));
    const int  lane = tid & 63, wave = tid >> 6, gw = blockIdx.x * NWAVES + wave, NGW = gridDim.x * NWAVES;
    for (int r0 = gw * 16; r0 < T; r0 += NGW * 16) {
        const float* mb = modl + (size_t)(r0 / SEQ) * 6144;
        f32x4 A[8], Bv[8];
#pragma unroll
        for (int j = 0; j < 8; ++j) { const int c = 4 * (64 * j + lane); const f32x4 gg = *(const f32x4*)(g + c), sc = *(const f32x4*)(mb + 2048 + c); A[j] = gg * (sc + 1.0f); Bv[j] = *(const f32x4*)(mb + c); }
        f32x4 v[8], vn[8];
        { const f32x4* xr = (const f32x4*)(xin + (size_t)r0 * DM) + lane;
#pragma unroll
          for (int j = 0; j < 8; ++j) v[j] = __builtin_nontemporal_load(xr + 64 * j); }
        for (int r = r0; r < r0 + 16; ++r) {
            { const int rn = r + 1 < r0 + 16 ? r + 1 : r; const f32x4* xr = (const f32x4*)(xin + (size_t)rn * DM) + lane;
#pragma unroll
              for (int j = 0; j < 8; ++j) vn[j] = __builtin_nontemporal_load(xr + 64 * j); }
            float s = 0.f;
#pragma unroll
            for (int j = 0; j < 8; ++j) s += (v[j][0] * v[j][0] + v[j][1] * v[j][1]) + (v[j][2] * v[j][2] + v[j][3] * v[j][3]);
            const float rstd = rsqrtf(wave_sum(s) * (1.0f / DM) + EPS);
            u32x2* o8 = (u32x2*)(H + (size_t)r * DM) + lane;
#pragma unroll
            for (int j = 0; j < 8; ++j) { const f32x4 y = v[j] * rstd * A[j] + Bv[j]; u32x2 w; w.x = cvtpk(y[0], y[1]); w.y = cvtpk(y[2], y[3]); o8[64 * j] = w; }
#pragma unroll
            for (int j = 0; j < 8; ++j) v[j] = vn[j];
        }
    }
}
__device__ __forceinline__ void norm_mod_pass_bf(const bf16_t* xin, const float* g, const float* modl, bf16_t* H) {
    int tid = threadIdx.x; asm volatile("" : "+v"(tid));
    const int lane = tid & 63, wave = tid >> 6, gw = blockIdx.x * NWAVES + wave, NGW = gridDim.x * NWAVES;
    for (int r0 = gw * 16; r0 < T; r0 += NGW * 16) {
        const float* mb = modl + (size_t)(r0 / SEQ) * 6144;
        f32x4 A[8], Bv[8];
#pragma unroll
        for (int j = 0; j < 4; ++j)
#pragma unroll
            for (int q = 0; q < 2; ++q) { const int c = 8 * (64 * j + lane) + 4 * q; const f32x4 gg = *(const f32x4*)(g + c), sc = *(const f32x4*)(mb + 2048 + c); A[2 * j + q] = gg * (sc + 1.0f); Bv[2 * j + q] = *(const f32x4*)(mb + c); }
        u32x4 v[4], vn[4];
        { const u32x4* xr = (const u32x4*)(xin + (size_t)r0 * DM) + lane;
#pragma unroll
          for (int j = 0; j < 4; ++j) v[j] = __builtin_nontemporal_load(xr + 64 * j); }
        for (int r = r0; r < r0 + 16; ++r) {
            { const int rn = r + 1 < r0 + 16 ? r + 1 : r; const u32x4* xr = (const u32x4*)(xin + (size_t)rn * DM) + lane;
#pragma unroll
              for (int j = 0; j < 4; ++j) vn[j] = __builtin_nontemporal_load(xr + 64 * j); }
            f32x4 f[8]; float s = 0.f;
#pragma unroll
            for (int j = 0; j < 4; ++j) { f[2 * j] = (f32x4){bflo(v[j].x), bfhi(v[j].x), bflo(v[j].y), bfhi(v[j].y)}; f[2 * j + 1] = (f32x4){bflo(v[j].z), bfhi(v[j].z), bflo(v[j].w), bfhi(v[j].w)}; }
#pragma unroll
            for (int j = 0; j < 8; ++j) s += (f[j][0] * f[j][0] + f[j][1] * f[j][1]) + (f[j][2] * f[j][2] + f[j][3] * f[j][3]);
            const float rstd = rsqrtf(wave_sum(s) * (1.0f / DM) + EPS);
            u32x4* o8 = (u32x4*)(H + (size_t)r * DM) + lane;
#pragma unroll
            for (int j = 0; j < 4; ++j) { const f32x4 y0 = f[2 * j] * rstd * A[2 * j] + Bv[2 * j], y1 = f[2 * j + 1] * rstd * A[2 * j + 1] + Bv[2 * j + 1];
                u32x4 w; w.x = cvtpk(y0[0], y0[1]); w.y = cvtpk(y0[2], y0[3]); w.z = cvtpk(y1[0], y1[1]); w.w = cvtpk(y1[2], y1[3]); o8[64 * j] = w; }
#pragma unroll
            for (int j = 0; j < 4; ++j) v[j] = vn[j];
        }
    }
}
__device__ __forceinline__ void groupnorm_pass(const bf16_t* O, bf16_t* SG) {
    int tid = threadIdx.x; asm volatile("" : "+v"(tid));
    const int lane = tid & 63, wave = tid >> 6, gw = blockIdx.x * NWAVES + wave, NGW = gridDim.x * NWAVES;
    u32x4 ovv[8], gvv[8], ovn[8], gvn[8];
    if (gw < T) { const size_t off0 = (size_t)gw * 4096 + lane * 8;
#pragma unroll
        for (int hh = 0; hh < 8; ++hh) { ovv[hh] = __builtin_nontemporal_load((const u32x4*)(O + off0 + hh * 512)); gvv[hh] = __builtin_nontemporal_load((const u32x4*)(SG + off0 + hh * 512)); } }
    for (int r = gw; r < T; r += NGW) {
        const size_t off0 = (size_t)r * 4096 + lane * 8;
        { const int rn = r + NGW < T ? r + NGW : r; const size_t offn = (size_t)rn * 4096 + lane * 8;
#pragma unroll
          for (int hh = 0; hh < 8; ++hh) { ovn[hh] = __builtin_nontemporal_load((const u32x4*)(O + offn + hh * 512)); gvn[hh] = __builtin_nontemporal_load((const u32x4*)(SG + offn + hh * 512)); } }
#pragma unroll
        for (int hh = 0; hh < 8; ++hh) {
            const u32x4 ov = ovv[hh], gv = gvv[hh];
            float v[8] = {bflo(ov.x), bfhi(ov.x), bflo(ov.y), bfhi(ov.y), bflo(ov.z), bfhi(ov.z), bflo(ov.w), bfhi(ov.w)};
            const float gg[8] = {bflo(gv.x), bfhi(gv.x), bflo(gv.y), bfhi(gv.y), bflo(gv.z), bfhi(gv.z), bflo(gv.w), bfhi(gv.w)};
            float s = 0.f;
#pragma unroll
            for (int j = 0; j < 8; ++j) s += v[j];
            const float mu = wave_sum(s) * (1.0f / 512.0f); float q = 0.f;
#pragma unroll
            for (int j = 0; j < 8; ++j) { v[j] -= mu; q += v[j] * v[j]; }
            const float rstd = rsqrtf(wave_sum(q) * (1.0f / 512.0f) + EPS);
            u32x4 w; w.x = cvtpk(v[0] * rstd * gg[0], v[1] * rstd * gg[1]); w.y = cvtpk(v[2] * rstd * gg[2], v[3] * rstd * gg[3]);
            w.z = cvtpk(v[4] * rstd * gg[4], v[5] * rstd * gg[5]); w.w = cvtpk(v[6] * rstd * gg[6], v[7] * rstd * gg[7]);
            *(u32x4*)(SG + off0 + hh * 512) = w;
        }
#pragma unroll
        for (int hh = 0; hh < 8; ++hh) { ovv[hh] = ovn[hh]; gvv[hh] = gvn[hh]; }
    }
}
__device__ __forceinline__ void final_norm_pass(const bf16_t* x2, float* xo, const float* g) {
    int tid = threadIdx.x; asm volatile("" : "+v"(tid));
    const int  lane = tid & 63, wave = tid >> 6, gw = blockIdx.x * NWAVES + wave, NGW = gridDim.x * NWAVES;
    f32x4 A[8];
#pragma unroll
    for (int j = 0; j < 4; ++j) { A[2 * j] = *(const f32x4*)(g + 8 * (64 * j + lane)); A[2 * j + 1] = *(const f32x4*)(g + 8 * (64 * j + lane) + 4); }
    u32x4 v[4], vn[4];
    if (gw < T) { const u32x4* xr = (const u32x4*)(x2 + (size_t)gw * DM) + lane;
#pragma unroll
        for (int j = 0; j < 4; ++j) v[j] = __builtin_nontemporal_load(xr + 64 * j); }
    for (int r = gw; r < T; r += NGW) {
        { const int rn = r + NGW < T ? r + NGW : r; const u32x4* xn = (const u32x4*)(x2 + (size_t)rn * DM) + lane;
#pragma unroll
          for (int j = 0; j < 4; ++j) vn[j] = __builtin_nontemporal_load(xn + 64 * j); }
        f32x4 f[8]; float s = 0.f;
#pragma unroll
        for (int j = 0; j < 4; ++j) { f[2 * j] = (f32x4){bflo(v[j].x), bfhi(v[j].x), bflo(v[j].y), bfhi(v[j].y)}; f[2 * j + 1] = (f32x4){bflo(v[j].z), bfhi(v[j].z), bflo(v[j].w), bfhi(v[j].w)}; }
#pragma unroll
        for (int j = 0; j < 8; ++j) s += (f[j][0] * f[j][0] + f[j][1] * f[j][1]) + (f[j][2] * f[j][2] + f[j][3] * f[j][3]);
        const float rstd = rsqrtf(wave_sum(s) * (1.0f / DM) + EPS);
        f32x4* xr = (f32x4*)(xo + (size_t)r * DM) + 2 * lane;
#pragma unroll
        for (int j = 0; j < 4; ++j) { __builtin_nontemporal_store(f[2 * j] * rstd * A[2 * j], xr + 128 * j); __builtin_nontemporal_store(f[2 * j + 1] * rstd * A[2 * j + 1], xr + 128 * j + 1); }
#pragma unroll
        for (int j = 0; j < 4; ++j) v[j] = vn[j];
    }
}

#define XB_TMO      128
#define XB_XCNT(j)  (256  + 64 * (j))
#define XB_XSUB(j)  (1280 + 64 * (j))
#define XB_XGEN(j)  (2304 + 64 * (j))
#define XB_TOP      3328
#define XB_TOPGEN   3392
#define XCD_BAR_WORDS 3456
#define XB_SPIN_CAP (1u << 18)

__device__ __forceinline__ unsigned xb_ld(unsigned* p)              { return __hip_atomic_load(p, __ATOMIC_RELAXED, __HIP_MEMORY_SCOPE_AGENT); }
__device__ __forceinline__ unsigned xb_add(unsigned* p, unsigned v) { return __hip_atomic_fetch_add(p, v, __ATOMIC_RELAXED, __HIP_MEMORY_SCOPE_AGENT); }
__device__ __forceinline__ unsigned xb_xcc_id() { return (unsigned)__builtin_amdgcn_s_getreg((3 << 11) | 20) & 0xFu; }
#define XB_SPIN(cond, bar) do { unsigned _sp = 0; while (cond) { __builtin_amdgcn_s_sleep(1); \
    if ((++_sp & 255u) == 0u) { if (xb_ld(&(bar)[XB_TMO])) break; if (_sp > XB_SPIN_CAP) { atomicAdd(&(bar)[XB_TMO], 1u); break; } } } } while (0)

struct XcdBarrier {
    unsigned* bar; unsigned x;
    volatile LAS unsigned* st;
};

__device__ __forceinline__ XcdBarrier xcd_barrier_post(unsigned* bar, volatile LAS unsigned* st) {
    XcdBarrier b; b.bar = bar; b.x = xb_xcc_id(); b.st = st;
    if (threadIdx.x == 0) (void)xb_add(&bar[XB_XCNT(b.x)], 1u);
    return b;
}
__device__ __forceinline__ void xcd_barrier_complete(unsigned* bar, unsigned x, unsigned& nloc, unsigned& nx) {
    const unsigned G = gridDim.x * gridDim.y * gridDim.z;
    unsigned sum, cnt, mine, sp = 0u;
    for (;;) {
        sum = 0u; cnt = 0u; mine = 0u;
#pragma unroll
        for (unsigned j = 0; j < 16; ++j) { const unsigned c = xb_ld(&bar[XB_XCNT(j)]); sum += c; cnt += (c > 0u) ? 1u : 0u; mine = (j == x) ? c : mine; }
        if (sum == G) break;
        __builtin_amdgcn_s_sleep(1);
        if ((++sp & 255u) == 0u) { if (xb_ld(&bar[XB_TMO])) break; if (sp > XB_SPIN_CAP) { atomicAdd(&bar[XB_TMO], 1u); break; } }
    }
    nloc = mine > 0u ? mine : 1u; nx = cnt > 0u ? cnt : 1u;
}

__device__ __forceinline__ void xcd_barrier(const XcdBarrier& b) {
    asm volatile("s_waitcnt vmcnt(0)" ::: "memory");
    __syncthreads();
    if (threadIdx.x == 0) {
        unsigned* bar = b.bar;
        __builtin_amdgcn_s_waitcnt(0);
        unsigned nloc = b.st[0], nx = b.st[1];
        if (nloc == 0u) { xcd_barrier_complete(bar, b.x, nloc, nx); b.st[0] = nloc; b.st[1] = nx; }
        const unsigned old = xb_add(&bar[XB_XSUB(b.x)], 1u);
        const unsigned gen = old / nloc;
        if (old + 1u == (gen + 1u) * nloc) {
            __builtin_amdgcn_fence(__ATOMIC_RELEASE, "agent");
            asm volatile("s_waitcnt vmcnt(0)" ::: "memory");
            const unsigned og = xb_add(&bar[XB_TOP], 1u);
            const unsigned tg = og / nx;
            if (og + 1u == (tg + 1u) * nx) xb_add(&bar[XB_TOPGEN], 1u);
            else XB_SPIN(xb_ld(&bar[XB_TOPGEN]) == tg, bar);
            __builtin_amdgcn_fence(__ATOMIC_ACQUIRE, "agent");
            xb_add(&bar[XB_XGEN(b.x)], 1u);
            asm volatile("s_waitcnt vmcnt(0)" ::: "memory");
        } else {
            XB_SPIN(xb_ld(&bar[XB_XGEN(b.x)]) == gen, bar);
            __builtin_amdgcn_fence(__ATOMIC_ACQUIRE, "agent");
            asm volatile("s_waitcnt vmcnt(0)" ::: "memory");
        }
    }
    __syncthreads();
}

constexpr int N_PHASES = 12;
constexpr size_t CTL_BAR = 640 * 1024, CTL_BAR_BYTES = 32 * 1024;
constexpr int LDS_BARST = 139264;

__global__ void __launch_bounds__(NTHREADS, 2) fwd_kernel(Args a) {
    extern __shared__ __attribute__((aligned(16))) unsigned char lds_raw[];
    LAS unsigned char* lds = (LAS unsigned char*)lds_raw;
    cg::grid_group grid = cg::this_grid();
    unsigned char* ws = a.ws; const int G = gridDim.x;
    float* mod = (float*)(ws + WS_CTL + CTL_MOD); float* ssq_q = (float*)(ws + WS_CTL + CTL_SSQQ); float* ssq_kv = (float*)(ws + WS_CTL + CTL_SSQKV);
    bf16_t* H = (bf16_t*)(ws + WS_H);
    if (threadIdx.x < 4) ((LAS unsigned*)(lds + LDS_BARST))[threadIdx.x] = 0u;
    __syncthreads();
    const XcdBarrier xbar = xcd_barrier_post((unsigned*)(ws + WS_CTL + CTL_BAR) + a.li * XCD_BAR_WORDS, (volatile LAS unsigned*)(lds + LDS_BARST));
    if (a.ph_lo < 0) grid.sync();
#ifndef PH_MASK
#define PH_MASK 0xFFF
#endif
#define IN(k) (((PH_MASK >> (k)) & 1) && a.ph_lo <= (k) && (k) < a.ph_hi)
#define SEAM(k) do { if (IN(k) && IN((k) + 1)) xcd_barrier(xbar); } while (0)
#ifdef PROBE_SYNCS
    if (a.ph_lo == 0) for (int i_ = 0; i_ < PROBE_SYNCS; ++i_) xcd_barrier(xbar);
#endif
    if (IN(0)) { prologue(a, lds); } SEAM(0);
    if (IN(1)) { norm_mod_pass(a.x, a.norm_g, mod, H); } SEAM(1);
    if (IN(2)) {
        pg8::Gemm g{H, (const bf16_t*)(ws + WS_WRIN), T, RET_IN, DM}; pg8::StaticOrder S; S.init(T, RET_IN, G, (int)blockIdx.x);
        pg8::EpiRetIn E{(bf16_t*)(ws + WS_Q), (bf16_t*)(ws + WS_K), (bf16_t*)(ws + WS_V), (bf16_t*)(ws + WS_SG), a.pos};
        pg8::gemm_phase<pg8::EpiRetIn, pg8::StaticOrder, true, true>(lds, g, S, E);
    } SEAM(2);
    if (IN(3)) {
        ret::retp_phase((LAS char*)lds, (const bf16_t*)(ws + WS_Q), (bf16_t*)(ws + WS_K), (bf16x8*)H);
        xcd_barrier(xbar);
        ret::ret_phase((LAS char*)lds, (const bf16_t*)(ws + WS_Q), (const bf16_t*)(ws + WS_K), (const bf16_t*)(ws + WS_V), (bf16_t*)a.out, (const bf16x8*)H);
#ifdef PROBE_REP_SCAN
        ret::ret_phase((LAS char*)lds, (const bf16_t*)(ws + WS_Q), (const bf16_t*)(ws + WS_K), (const bf16_t*)(ws + WS_V), (bf16_t*)a.out, (const bf16x8*)H);
#endif
    } SEAM(3);
    if (IN(4)) { groupnorm_pass((const bf16_t*)a.out, (bf16_t*)(ws + WS_SG)); } SEAM(4);
    if (IN(5)) {
        pg8::Gemm g{(const bf16_t*)(ws + WS_SG), (const bf16_t*)(ws + WS_WROUT), T, DM, RET_W}; pg8::StaticOrder S; S.init(T, DM, G, (int)blockIdx.x);
        pg8::EpiResidBf E{a.x, (bf16_t*)a.out, mod + 4096};
        pg8::gemm_phase<pg8::EpiResidBf, pg8::StaticOrder, true, true>(lds, g, S, E);
    } SEAM(5);
    if (IN(6)) { norm_mod_pass_bf((const bf16_t*)a.out, a.norm_g + DM, mod + 4 * 6144, H); } SEAM(6);
    if (IN(7)) {
        pg8::Gemm g{H, (const bf16_t*)(ws + WS_WMIN), T, MLA_INP, DM}; pg8::StaticOrder S; S.init(T, MLA_INP, G, (int)blockIdx.x);
        pg8::EpiMlaIn E{(bf16_t*)(ws + WS_CQ), (bf16_t*)(ws + WS_CKV), (bf16_t*)(ws + WS_SG1), (bf16_t*)(ws + WS_KR), ssq_q, ssq_kv, a.pos};
        pg8::gemm_phase<pg8::EpiMlaIn, pg8::StaticOrder, true, true>(lds, g, S, E);
    } SEAM(7);
    if (IN(8)) {
        { pg8::Gemm g{(const bf16_t*)(ws + WS_CQ), (const bf16_t*)(ws + WS_WUQ), T, 3072, 512}; pg8::StaticOrder S; S.init(T, 3072, G, (int)blockIdx.x);
          pg8::EpiQUp E{(bf16_t*)(ws + WS_QN), (bf16_t*)(ws + WS_QRP), ssq_q, a.pos};
          pg8::gemm_phase<pg8::EpiQUp, pg8::StaticOrder, true, true>(lds, g, S, E); }
        { pg8::Gemm g{(const bf16_t*)(ws + WS_CKV), (const bf16_t*)(ws + WS_WUKV), T, 4096, 512}; pg8::StaticOrder S; S.init(T, 4096, G, (int)blockIdx.x);
          pg8::EpiKvUp E{(bf16_t*)(ws + WS_KN), (bf16_t*)(ws + WS_V1), ssq_kv};
          pg8::gemm_phase<pg8::EpiKvUp, pg8::StaticOrder, true, true>(lds, g, S, E); }
    } SEAM(8);
    if (IN(9)) {
        const att::Tensors Tn{(const bf16_t*)(ws + WS_QN), (const bf16_t*)(ws + WS_QRP), (const bf16_t*)(ws + WS_KN), (const bf16_t*)(ws + WS_KR), (const bf16_t*)(ws + WS_V1), (const bf16_t*)(ws + WS_SG1), H};
        att::attn_phase((char*)lds_raw, Tn);
    } SEAM(9);
    if (IN(10)) {
        pg8::Gemm g{H, (const bf16_t*)(ws + WS_WMOUT), T, DM, MLA_W}; pg8::StaticOrder S; S.init(T, DM, G, (int)blockIdx.x);
        pg8::EpiResidBf2 E{(const bf16_t*)a.out, (bf16_t*)(ws + WS_QN), mod + 4 * 6144 + 4096};
        pg8::gemm_phase<pg8::EpiResidBf2, pg8::StaticOrder, true, true>(lds, g, S, E);
    } SEAM(10);
    if (IN(11)) { final_norm_pass((const bf16_t*)(ws + WS_QN), a.out, a.final_g); }
#undef IN
#undef SEAM
}

#ifndef MK_LAUNCHES
#define MK_LAUNCHES 1
#endif
extern "C" void kernel_launch(void* const* d_in, const int* in_sizes, int n_in, void* d_out, int out_size, void* d_ws, size_t ws_size, hipStream_t stream) {
    static int grid = 0;
    if (grid == 0) {
        if (n_in != 16 || in_sizes[0] != T * DM || out_size != T * DM || ws_size < WS_END) {
            fprintf(stderr, "kernel_launch: unexpected shapes (n_in %d, in0 %d, out %d, ws %zu); nothing launched\n", n_in, n_in > 0 ? in_sizes[0] : -1, out_size, ws_size); grid = -1; return; }
        int dev = 0, cus = 0, per_cu = 0;
        (void)hipGetDevice(&dev); (void)hipDeviceGetAttribute(&cus, hipDeviceAttributeMultiprocessorCount, dev);
        if (hipFuncSetAttribute((const void*)fwd_kernel, hipFuncAttributeMaxDynamicSharedMemorySize, LDS_BYTES) != hipSuccess) { fprintf(stderr, "kernel_launch: hipFuncSetAttribute failed\n"); grid = -1; return; }
        if (hipOccupancyMaxActiveBlocksPerMultiprocessor(&per_cu, (const void*)fwd_kernel, NTHREADS, LDS_BYTES) != hipSuccess || per_cu < 1) { fprintf(stderr, "kernel_launch: occupancy query says %d blocks/CU\n", per_cu); per_cu = 1; }
        (void)hipGetLastError();
        grid = cus > 0 ? cus : 256;
    }
    if (grid < 0) return;
    Args a{};
    a.x = (const float*)d_in[0]; a.c = (const float*)d_in[1]; a.pos = (const int*)d_in[2]; a.ada_w = (const float*)d_in[3]; a.ada_b = (const float*)d_in[4]; a.norm_g = (const float*)d_in[5];
    a.ret_w_in = (const float*)d_in[6]; a.ret_gn_g = (const float*)d_in[7]; a.ret_w_out = (const float*)d_in[8]; a.mla_w_in = (const float*)d_in[9]; a.mla_qn_g = (const float*)d_in[10];
    a.mla_w_uq = (const float*)d_in[11]; a.mla_kvn_g = (const float*)d_in[12]; a.mla_w_ukv = (const float*)d_in[13]; a.mla_w_out = (const float*)d_in[14]; a.final_g = (const float*)d_in[15];
    a.out = (float*)d_out; a.ws = (unsigned char*)d_ws;
    if (MK_LAUNCHES == 1) {
        if (hipMemsetAsync((unsigned char*)d_ws + WS_CTL + CTL_BAR, 0, CTL_BAR_BYTES, stream) != hipSuccess) { fprintf(stderr, "kernel_launch: memset of the barrier words failed\n"); return; }
#ifdef PROBE_REP_PHASE
        const int cuts[3] = {0, PROBE_REP_PHASE + 1, N_PHASES};
        for (int li = 0; li < 2; ++li) { a.ph_lo = li ? PROBE_REP_PHASE : 0; a.ph_hi = cuts[li + 1]; a.li = li; void* args[] = {&a};
            const hipError_t e = hipLaunchCooperativeKernel((const void*)fwd_kernel, dim3(grid), dim3(NTHREADS), args, LDS_BYTES, stream);
            if (e != hipSuccess) fprintf(stderr, "kernel_launch: cooperative launch failed: %s (grid %d)\n", hipGetErrorString(e), grid); }
#else
        a.ph_lo = 0; a.ph_hi = N_PHASES;
        void* args[] = {&a};
        const hipError_t e = hipLaunchCooperativeKernel((const void*)fwd_kernel, dim3(grid), dim3(NTHREADS), args, LDS_BYTES, stream);
        if (e != hipSuccess) fprintf(stderr, "kernel_launch: cooperative launch failed: %s (grid %d)\n", hipGetErrorString(e), grid);
#endif
    } else {
        for (int p = 0; p < N_PHASES; ++p) { a.ph_lo = p; a.ph_hi = p + 1; hipLaunchKernelGGL(fwd_kernel, dim3(grid), dim3(NTHREADS), LDS_BYTES, stream, a); }
    }
}
```

```cpp
#include <hip/hip_runtime.h>
#include <hip/hip_bf16.h>
#include <hip/hip_cooperative_groups.h>
#include <cstdio>
#include <cstdint>
namespace cg = cooperative_groups;

constexpr int BATCH = 4, SEQ = 8192, DM = 2048, T = BATCH * SEQ;
constexpr int RET_H = 8, RET_DK = 256, RET_DV = 512, RET_W = 4096, RET_QK = 2048, RET_IN = 12288;
constexpr int MLA_H = 16, MLA_NOPE = 128, MLA_ROPE = 64, MLA_V = 128, MLA_QR = 512, MLA_KVR = 512, MLA_W = 2048, MLA_IN = 3136, MLA_INP = 3328;
constexpr float EPS = 1e-6f;
constexpr size_t MiB = 1u << 20;
constexpr size_t WS_WRIN = 0 * MiB, WS_WROUT = 48 * MiB, WS_WMIN = 64 * MiB, WS_WUQ = 77 * MiB, WS_WUKV = 80 * MiB, WS_WMOUT = 84 * MiB;
constexpr size_t WS_CTL = 92 * MiB;
constexpr size_t CTL_MOD = 0, CTL_SSQQ = 256 * 1024, CTL_SSQKV = 384 * 1024;
constexpr size_t WS_H = 96 * MiB;
constexpr size_t WS_Q = 224 * MiB, WS_K = 352 * MiB, WS_V = 480 * MiB, WS_SG = 736 * MiB;
constexpr size_t WS_CQ = 224 * MiB, WS_CKV = 256 * MiB, WS_KR = 288 * MiB, WS_SG1 = 296 * MiB, WS_QN = 424 * MiB, WS_QRP = 552 * MiB, WS_KN = 616 * MiB, WS_V1 = 744 * MiB;
constexpr size_t WS_END = 992 * MiB;

#define LAS __attribute__((address_space(3)))
typedef unsigned short bf16_t;
typedef short bf16x8 __attribute__((ext_vector_type(8)));
typedef short s16x4 __attribute__((ext_vector_type(4)));
typedef float f32x4 __attribute__((ext_vector_type(4)));
typedef float f32x16 __attribute__((ext_vector_type(16)));
typedef unsigned u32x4 __attribute__((ext_vector_type(4)));
typedef unsigned u32x2 __attribute__((ext_vector_type(2)));

__device__ __forceinline__ unsigned cvtpk(float lo, float hi) { unsigned r; asm volatile("v_cvt_pk_bf16_f32 %0, %1, %2" : "=v"(r) : "v"(lo), "v"(hi)); return r; }
__device__ __forceinline__ float bf2f(unsigned short b) { return __uint_as_float(((unsigned)b) << 16); }
__device__ __forceinline__ float bflo(unsigned w) { return __uint_as_float(w << 16); }
__device__ __forceinline__ float bfhi(unsigned w) { return __uint_as_float(w & 0xffff0000u); }
__device__ __forceinline__ float silu_f(float v) { return v / (1.0f + __expf(-v)); }
__device__ __forceinline__ float wave_sum(float v) {
#pragma unroll
    for (int o = 1; o < 64; o <<= 1) v += __shfl_xor(v, o);
    return v;
}
__device__ __forceinline__ void sincos_rr(float ang, float& s, float& c) {
    const float k = rintf(ang * 0.15915494309189535f);
    float r = fmaf(-k, 6.2831854820251465f, ang);
    r = fmaf(-k, -1.7484555e-7f, r);
    const float rev = r * 0.15915494309189535f;
    s = __builtin_amdgcn_sinf(rev); c = __builtin_amdgcn_cosf(rev);
}

__device__ const float INVF256[128] __attribute__((aligned(16))) = {1.000000000e+00f, 9.305720329e-01f, 8.659643531e-01f, 8.058421612e-01f, 7.498942018e-01f, 6.978305578e-01f, 6.493816376e-01f, 6.042963862e-01f, 5.623413324e-01f, 5.232990980e-01f, 4.869675338e-01f, 4.531583786e-01f, 4.216965139e-01f, 3.924189806e-01f, 3.651741147e-01f, 3.398208320e-01f, 3.162277639e-01f, 2.942727208e-01f, 2.738419771e-01f, 2.548296750e-01f, 2.371373773e-01f, 2.206734121e-01f, 2.053525001e-01f, 1.910952926e-01f, 1.778279394e-01f, 1.654817164e-01f, 1.539926529e-01f, 1.433012635e-01f, 1.333521456e-01f, 1.240937784e-01f, 1.154781953e-01f, 1.074607819e-01f, 1.000000015e-01f, 9.305720776e-02f, 8.659642935e-02f, 8.058422059e-02f, 7.498942316e-02f, 6.978306174e-02f, 6.493816525e-02f, 6.042964011e-02f, 5.623413250e-02f, 5.232991278e-02f, 4.869675264e-02f, 4.531583562e-02f, 4.216964915e-02f, 3.924189880e-02f, 3.651741147e-02f, 3.398208320e-02f, 3.162277490e-02f, 2.942727134e-02f, 2.738419548e-02f, 2.548296750e-02f, 2.371373773e-02f, 2.206734009e-02f, 2.053525113e-02f, 1.910953037e-02f, 1.778279431e-02f, 1.654817164e-02f, 1.539926510e-02f, 1.433012541e-02f, 1.333521400e-02f, 1.240937784e-02f, 1.154781971e-02f, 1.074607857e-02f, 9.999999776e-03f, 9.305720218e-03f, 8.659643121e-03f, 8.058422245e-03f, 7.498942316e-03f, 6.978305988e-03f, 6.493816152e-03f, 6.042963825e-03f, 5.623413250e-03f, 5.232991185e-03f, 4.869675264e-03f, 4.531583749e-03f, 4.216964822e-03f, 3.924189601e-03f, 3.651741194e-03f, 3.398208413e-03f, 3.162277630e-03f, 2.942727180e-03f, 2.738419687e-03f, 2.548296703e-03f, 2.371373819e-03f, 2.206734149e-03f, 2.053525066e-03f, 1.910952968e-03f, 1.778279431e-03f, 1.654817141e-03f, 1.539926510e-03f, 1.433012541e-03f, 1.333521446e-03f, 1.240937738e-03f, 1.154782018e-03f, 1.074607833e-03f, 1.000000047e-03f, 9.305720450e-04f, 8.659643354e-04f, 8.058421663e-04f, 7.498941850e-04f, 6.978305755e-04f, 6.493816036e-04f, 6.042963942e-04f, 5.623413017e-04f, 5.232990952e-04f, 4.869675322e-04f, 4.531583691e-04f, 4.216965172e-04f, 3.924189659e-04f, 3.651741135e-04f, 3.398208355e-04f, 3.162277571e-04f, 2.942727297e-04f, 2.738419571e-04f, 2.548296761e-04f, 2.371373703e-04f, 2.206734061e-04f, 2.053525095e-04f, 1.910952997e-04f, 1.778279402e-04f, 1.654817170e-04f, 1.539926598e-04f, 1.433012512e-04f, 1.333521504e-04f, 1.240937709e-04f, 1.154782003e-04f, 1.074607862e-04f};
__device__ const float INVF64[32] __attribute__((aligned(16))) = {1.000000000e+00f, 7.498942018e-01f, 5.623413324e-01f, 4.216965139e-01f, 3.162277639e-01f, 2.371373773e-01f, 1.778279394e-01f, 1.333521456e-01f, 1.000000015e-01f, 7.498942316e-02f, 5.623413250e-02f, 4.216964915e-02f, 3.162277490e-02f, 2.371373773e-02f, 1.778279431e-02f, 1.333521400e-02f, 9.999999776e-03f, 7.498942316e-03f, 5.623413250e-03f, 4.216964822e-03f, 3.162277630e-03f, 2.371373819e-03f, 1.778279431e-03f, 1.333521446e-03f, 1.000000047e-03f, 7.498941850e-04f, 5.623413017e-04f, 4.216965172e-04f, 3.162277571e-04f, 2.371373703e-04f, 1.778279402e-04f, 1.333521504e-04f};
namespace pg8 {
#define PG8_LAS __attribute__((address_space(3)))
typedef unsigned short bf16_t;
typedef short bf16x8 __attribute__((ext_vector_type(8)));
typedef float f32x4 __attribute__((ext_vector_type(4)));
typedef unsigned u32x4 __attribute__((ext_vector_type(4)));
constexpr int BM = 256, BK = 64, HALF = 128, HTB = HALF * BK * 2  , STAGE_BYTES = 8 * HTB, NXCD = 8, WGM = 8;

__host__ __device__ __forceinline__ int lds_byte(int r, int c) { const int st = (r >> 4) * 2 + (c >> 5), rr = r & 15, cc = c & 31, ob = rr * 64 + cc * 2; return st * 1024 + (ob ^ (((ob >> 9) & 1) << 5)); }
__host__ __device__ __forceinline__ void stage_rc(int b, int& R, int& C) { const int st = b / 1024, sb = b % 1024, swz = sb ^ (((sb >> 9) & 1) << 5); R = (st >> 1) * 16 + swz / 64; C = (st & 1) * 32 + (swz % 64) / 2; }
__host__ __device__ __forceinline__ int perm32(int rho) { const int n = rho >> 4, i = rho & 15; return 8 * (i >> 2) + 4 * n + (i & 3); }

struct Unit { int pm, pn; };
struct Gemm { const bf16_t* A; const bf16_t* Bt; int M, N, K; };

struct StaticOrder {
    int nM, nN, nwg, G, c;
    __host__ __device__ void init(int M, int N, int G_, int c_) { nM = M / BM; nN = N / BM; nwg = nM * nN; G = G_; c = c_; }
    __host__ __device__ bool next(int i, Unit& u) const {
        const long L = (long)i * G + c; if (L >= nwg) return false;
        int wgid = (int)L; { const int q = nwg / NXCD, r = nwg % NXCD, xcd = wgid % NXCD, off = wgid / NXCD; wgid = (xcd < r ? xcd * (q + 1) : r * (q + 1) + (xcd - r) * q) + off; }
        const int nig = WGM * nN, gid = wgid / nig, fm = gid * WGM, gsz = (nM - fm) < WGM ? (nM - fm) : WGM;
        u.pm = fm + ((wgid % nig) % gsz); u.pn = (wgid % nig) / gsz; return true;
    }
    __device__ __forceinline__ void a_ready(const Unit&) const {}
    __device__ __forceinline__ void done(const Unit&) const {}
};

__device__ __forceinline__ unsigned cvt_pk_bf16(float lo, float hi) { unsigned r; asm volatile("v_cvt_pk_bf16_f32 %0, %1, %2" : "=v"(r) : "v"(lo), "v"(hi)); return r; }
typedef float f32x2 __attribute__((ext_vector_type(2)));
__device__ __forceinline__ void st8(bf16_t* p, f32x4 v0, f32x4 v1) {
    u32x4 w; w.x = cvt_pk_bf16(v0[0], v0[1]); w.y = cvt_pk_bf16(v0[2], v0[3]); w.z = cvt_pk_bf16(v1[0], v1[1]); w.w = cvt_pk_bf16(v1[2], v1[3]);
    *(u32x4*)p = w;
}
__device__ __forceinline__ f32x4 silu4(f32x4 v) { f32x4 o; o[0] = silu_f(v[0]); o[1] = silu_f(v[1]); o[2] = silu_f(v[2]); o[3] = silu_f(v[3]); return o; }

struct EpiRetIn {
    static constexpr bool PERM = true, AFTER_DRAIN = false;
    bf16_t *Q, *K, *V, *SG; const int* pos;
    __device__ __forceinline__ void operator()(const f32x4 (&acc)[2][2][4][2], const Unit& u, int wr, int wc, int fr, int fq) const {
        const int row0 = u.pm * BM + wr * 64 + fr, cl = wc * 32 + 8 * fq;
        if (u.pn < 16) {
            const bool isk = u.pn >= 8; const int head = u.pn & 7;
            bf16_t* base = (isk ? K : Q) + head * 256 + cl;
            f32x4 invf[2];
#pragma unroll
            for (int bj = 0; bj < 2; ++bj) invf[bj] = *(const f32x4*)(INVF256 + 64 * bj + 16 * wc + 4 * fq);
            const float lg = __log2f(1.0f - exp2f(-5.0f - (float)head));
#pragma unroll
            for (int ai = 0; ai < 2; ++ai)
#pragma unroll
                for (int m = 0; m < 4; ++m) {
                    const int row = row0 + ai * HALF + m * 16; const float p = (float)pos[row];
                    const float jj = (float)(wr * 64 + m * 16 + fr + 1);
                    const float dec = isk ? 0.0625f * exp2f(-lg * jj) : exp2f(lg * jj);
#pragma unroll
                    for (int bj = 0; bj < 2; ++bj) { f32x4 o0, o1;
#pragma unroll
                        for (int e = 0; e < 4; ++e) { float s, c; sincos_rr(p * invf[bj][e], s, c);
                            const float x1 = acc[ai][bj][m][0][e], x2 = acc[ai][bj][m][1][e];
                            o0[e] = (x1 * c - x2 * s) * dec; o1[e] = (x2 * c + x1 * s) * dec; }
                        st8(base + (size_t)row * 2048 + bj * HALF, o0, o1); }
                }
        } else {
            const bool isg = u.pn >= 32; bf16_t* base = (isg ? SG + (u.pn - 32) * 256 : V + (u.pn - 16) * 256) + cl;
#pragma unroll
            for (int ai = 0; ai < 2; ++ai)
#pragma unroll
                for (int m = 0; m < 4; ++m) { bf16_t* rowp = base + (size_t)(row0 + ai * HALF + m * 16) * 4096;
#pragma unroll
                    for (int bj = 0; bj < 2; ++bj) { f32x4 v0 = acc[ai][bj][m][0], v1 = acc[ai][bj][m][1];
                        if (isg) { v0 = silu4(v0); v1 = silu4(v1); }
                        st8(rowp + bj * HALF, v0, v1); } }
        }
    }
};
struct EpiResid {
    static constexpr bool PERM = false, AFTER_DRAIN = false;
    const float* base; float* out; const float* gate;
    __device__ __forceinline__ void operator()(const f32x4 (&acc)[2][2][4][2], const Unit& u, int wr, int wc, int fr, int fq) const {
        const int row0 = u.pm * BM + wr * 64 + fr, col0 = u.pn * BM + wc * 32 + 4 * fq;
        const float* gv = gate + (size_t)((u.pm * BM) / SEQ) * 6144 + col0;
        f32x4 g[2][2];
#pragma unroll
        for (int bj = 0; bj < 2; ++bj)
#pragma unroll
            for (int n = 0; n < 2; ++n) g[bj][n] = *(const f32x4*)(gv + bj * HALF + n * 16);
#pragma unroll
        for (int ai = 0; ai < 2; ++ai)
#pragma unroll
            for (int m = 0; m < 4; ++m) { const size_t off = (size_t)(row0 + ai * HALF + m * 16) * 2048 + col0;
#pragma unroll
                for (int bj = 0; bj < 2; ++bj)
#pragma unroll
                    for (int n = 0; n < 2; ++n) { const f32x4 b = *(const f32x4*)(base + off + bj * HALF + n * 16);
                        *(f32x4*)(out + off + bj * HALF + n * 16) = b + g[bj][n] * acc[ai][bj][m][n]; } }
    }
};
struct EpiResidBf {
    static constexpr bool PERM = false, AFTER_DRAIN = false;
    const float* base; bf16_t* out; const float* gate;
    __device__ __forceinline__ void operator()(const f32x4 (&acc)[2][2][4][2], const Unit& u, int wr, int wc, int fr, int fq) const {
        const int row0 = u.pm * BM + wr * 64 + fr, col0 = u.pn * BM + wc * 32 + 4 * fq;
        const float* gv = gate + (size_t)((u.pm * BM) / SEQ) * 6144 + col0;
        f32x4 g[2][2];
#pragma unroll
        for (int bj = 0; bj < 2; ++bj)
#pragma unroll
            for (int n = 0; n < 2; ++n) g[bj][n] = *(const f32x4*)(gv + bj * HALF + n * 16);
#pragma unroll
        for (int ai = 0; ai < 2; ++ai)
#pragma unroll
            for (int m = 0; m < 4; ++m) { const size_t off = (size_t)(row0 + ai * HALF + m * 16) * 2048 + col0;
#pragma unroll
                for (int bj = 0; bj < 2; ++bj)
#pragma unroll
                    for (int n = 0; n < 2; ++n) { const f32x4 b = *(const f32x4*)(base + off + bj * HALF + n * 16); const f32x4 o = b + g[bj][n] * acc[ai][bj][m][n];
                        u32x2 w; w.x = cvt_pk_bf16(o[0], o[1]); w.y = cvt_pk_bf16(o[2], o[3]); *(u32x2*)(out + off + bj * HALF + n * 16) = w; } }
    }
};
struct EpiResidBf2 {
    static constexpr bool PERM = false, AFTER_DRAIN = false;
    const bf16_t* base; bf16_t* out; const float* gate;
    __device__ __forceinline__ void operator()(const f32x4 (&acc)[2][2][4][2], const Unit& u, int wr, int wc, int fr, int fq) const {
        const int row0 = u.pm * BM + wr * 64 + fr, col0 = u.pn * BM + wc * 32 + 4 * fq;
        const float* gv = gate + (size_t)((u.pm * BM) / SEQ) * 6144 + col0;
        f32x4 g[2][2];
#pragma unroll
        for (int bj = 0; bj < 2; ++bj)
#pragma unroll
            for (int n = 0; n < 2; ++n) g[bj][n] = *(const f32x4*)(gv + bj * HALF + n * 16);
#pragma unroll
        for (int ai = 0; ai < 2; ++ai)
#pragma unroll
            for (int m = 0; m < 4; ++m) { const size_t off = (size_t)(row0 + ai * HALF + m * 16) * 2048 + col0;
#pragma unroll
                for (int bj = 0; bj < 2; ++bj)
#pragma unroll
                    for (int n = 0; n < 2; ++n) { const u32x2 bw = *(const u32x2*)(base + off + bj * HALF + n * 16);
                        const f32x4 b = {bflo(bw.x), bfhi(bw.x), bflo(bw.y), bfhi(bw.y)}; const f32x4 o = b + g[bj][n] * acc[ai][bj][m][n];
                        u32x2 w; w.x = cvt_pk_bf16(o[0], o[1]); w.y = cvt_pk_bf16(o[2], o[3]); *(u32x2*)(out + off + bj * HALF + n * 16) = w; } }
    }
};
struct EpiMlaIn {
    static constexpr bool PERM = true, AFTER_DRAIN = false;
    bf16_t *CQ, *CKV, *SG1, *KR; float *ssq_q, *ssq_kv; const int* pos;
    __device__ __forceinline__ void operator()(const f32x4 (&acc)[2][2][4][2], const Unit& u, int wr, int wc, int fr, int fq) const {
        const int row0 = u.pm * BM + wr * 64 + fr, cl = wc * 32 + 8 * fq;
        if (u.pn < 4) {
            bf16_t* base = (u.pn < 2 ? CQ : CKV) + (u.pn & 1) * 256 + cl; float* ssq = u.pn < 2 ? ssq_q : ssq_kv;
#pragma unroll
            for (int ai = 0; ai < 2; ++ai)
#pragma unroll
                for (int m = 0; m < 4; ++m) { const int row = row0 + ai * HALF + m * 16; float s = 0.f;
#pragma unroll
                    for (int bj = 0; bj < 2; ++bj) { const f32x4 v0 = acc[ai][bj][m][0], v1 = acc[ai][bj][m][1];
                        s += (v0[0] * v0[0] + v0[1] * v0[1]) + (v0[2] * v0[2] + v0[3] * v0[3]) + (v1[0] * v1[0] + v1[1] * v1[1]) + (v1[2] * v1[2] + v1[3] * v1[3]);
                        st8(base + (size_t)row * 512 + bj * HALF, v0, v1); }
                    s += __shfl_xor(s, 16); s += __shfl_xor(s, 32);
                    if (fq == 0) atomicAdd(ssq + row, s); }
        } else if (u.pn < 12) {
            bf16_t* base = SG1 + (u.pn - 4) * 256 + cl;
#pragma unroll
            for (int ai = 0; ai < 2; ++ai)
#pragma unroll
                for (int m = 0; m < 4; ++m) { bf16_t* rowp = base + (size_t)(row0 + ai * HALF + m * 16) * 2048;
#pragma unroll
                    for (int bj = 0; bj < 2; ++bj) st8(rowp + bj * HALF, silu4(acc[ai][bj][m][0]), silu4(acc[ai][bj][m][1])); }
        } else if (wc < 2) {
            const f32x4 invf = *(const f32x4*)(INVF64 + 16 * wc + 4 * fq);
#pragma unroll
            for (int ai = 0; ai < 2; ++ai)
#pragma unroll
                for (int m = 0; m < 4; ++m) { const int row = row0 + ai * HALF + m * 16; const float p = (float)pos[row]; f32x4 o0, o1;
#pragma unroll
                    for (int e = 0; e < 4; ++e) { float s, c; sincos_rr(p * invf[e], s, c);
                        const float x1 = acc[ai][0][m][0][e], x2 = acc[ai][0][m][1][e];
                        o0[e] = x1 * c - x2 * s; o1[e] = x2 * c + x1 * s; }
                    st8(KR + (size_t)row * 64 + cl, o0, o1); }
        }
    }
};
struct EpiQUp {
    static constexpr bool PERM = true, AFTER_DRAIN = false;
    bf16_t *QN, *QR; const float* ssq; const int* pos;
    __device__ __forceinline__ void operator()(const f32x4 (&acc)[2][2][4][2], const Unit& u, int wr, int wc, int fr, int fq) const {
        const int row0 = u.pm * BM + wr * 64 + fr, cl = wc * 32 + 8 * fq;
        if (u.pn < 8) {
            bf16_t* base = QN + u.pn * 256 + cl;
#pragma unroll
            for (int ai = 0; ai < 2; ++ai)
#pragma unroll
                for (int m = 0; m < 4; ++m) { const int row = row0 + ai * HALF + m * 16; const float rs = rsqrtf(ssq[row] * (1.0f / 512.0f) + EPS);
#pragma unroll
                    for (int bj = 0; bj < 2; ++bj) st8(base + (size_t)row * 2048 + bj * HALF, acc[ai][bj][m][0] * rs, acc[ai][bj][m][1] * rs); }
        } else {
            const f32x4 invf = *(const f32x4*)(INVF64 + 16 * (wc & 1) + 4 * fq);
#pragma unroll
            for (int ai = 0; ai < 2; ++ai)
#pragma unroll
                for (int m = 0; m < 4; ++m) { const int row = row0 + ai * HALF + m * 16; const float rs = rsqrtf(ssq[row] * (1.0f / 512.0f) + EPS); const float p = (float)pos[row];
                    float sn[4], cs[4];
#pragma unroll
                    for (int e = 0; e < 4; ++e) sincos_rr(p * invf[e], sn[e], cs[e]);
#pragma unroll
                    for (int bj = 0; bj < 2; ++bj) { const int head = 4 * (u.pn - 8) + 2 * bj + (wc >> 1); f32x4 o0, o1;
#pragma unroll
                        for (int e = 0; e < 4; ++e) { const float x1 = acc[ai][bj][m][0][e] * rs, x2 = acc[ai][bj][m][1][e] * rs;
                            o0[e] = x1 * cs[e] - x2 * sn[e]; o1[e] = x2 * cs[e] + x1 * sn[e]; }
                        st8(QR + (size_t)row * 1024 + head * 64 + 32 * (wc & 1) + 8 * fq, o0, o1); } }
        }
    }
};
struct EpiKvUp {
    static constexpr bool PERM = true, AFTER_DRAIN = false;
    bf16_t *KN, *V1; const float* ssq;
    __device__ __forceinline__ void operator()(const f32x4 (&acc)[2][2][4][2], const Unit& u, int wr, int wc, int fr, int fq) const {
        const int row0 = u.pm * BM + wr * 64 + fr, cl = wc * 32 + 8 * fq;
        bf16_t* base = (u.pn < 8 ? KN + u.pn * 256 : V1 + (u.pn - 8) * 256) + cl;
#pragma unroll
        for (int ai = 0; ai < 2; ++ai)
#pragma unroll
            for (int m = 0; m < 4; ++m) { const int row = row0 + ai * HALF + m * 16; const float rs = rsqrtf(ssq[row] * (1.0f / 512.0f) + EPS);
#pragma unroll
                for (int bj = 0; bj < 2; ++bj) st8(base + (size_t)row * 2048 + bj * HALF, acc[ai][bj][m][0] * rs, acc[ai][bj][m][1] * rs); }
    }
};

template <class Epi, class Sched, bool ALIGN_EPI = false, bool SP2 = false>
__device__ __forceinline__ void gemm_phase(PG8_LAS unsigned char* lds, const Gemm g, const Sched& S, const Epi& E) {
    const int tid = threadIdx.x, wid = __builtin_amdgcn_readfirstlane(tid >> 6), lane = tid & 63, wr = wid >> 2, wc = wid & 3, fr = lane & 15, fq = lane >> 4;
    const int K = g.K, nt = K / BK;
    unsigned voffA[2], voffB[2];
#pragma unroll
    for (int i = 0; i < 2; ++i) { int R, C; stage_rc(tid * 16 + i * 8192, R, C); const int Rb = Epi::PERM ? ((R & ~31) + perm32(R & 31)) : R;
        voffA[i] = (unsigned)(R * K + C) * 2u; voffB[i] = (unsigned)(Rb * K + C) * 2u; }
    const size_t kstep = (size_t)(BK * 2);
    const size_t hstep = (size_t)HALF * K * 2;
    const size_t tstep = 2 * hstep;
    const unsigned ldsw = (unsigned)wid * 1024u;
    const int aoff = lds_byte(wr * 64 + fr, fq * 8), boff = lds_byte(wc * 32 + fr, fq * 8);
#define PG8_SA(b, h) (((b) * 2 + (h)) * HTB)
#define PG8_SB(b, h) ((4 + (b) * 2 + (h)) * HTB)
#define PG8_STAGE(bufoff, gbase, voff) do { _Pragma("unroll") for (int _i = 0; _i < 2; ++_i) \
        __builtin_amdgcn_global_load_lds((const unsigned*)((const char*)(gbase) + (voff)[_i]), (PG8_LAS unsigned*)(lds + (bufoff) + ldsw + _i * 8192), 16, 0, 0); } while (0)
#define PG8_LDA(dst, b, h) do { _Pragma("unroll") for (int m = 0; m < 4; ++m) _Pragma("unroll") for (int k = 0; k < 2; ++k) dst[m][k] = *(const PG8_LAS bf16x8*)(lds + PG8_SA(b, h) + aoff + m * 2048 + k * 1024); } while (0)
#define PG8_LDB(dst, b, h) do { _Pragma("unroll") for (int n = 0; n < 2; ++n) _Pragma("unroll") for (int k = 0; k < 2; ++k) dst[n][k] = *(const PG8_LAS bf16x8*)(lds + PG8_SB(b, h) + boff + n * 2048 + k * 1024); } while (0)
#define PG8_MMA(ai, bj, At, Bt) do { __builtin_amdgcn_s_setprio(1); _Pragma("unroll") for (int m = 0; m < 4; ++m) _Pragma("unroll") for (int n = 0; n < 2; ++n) _Pragma("unroll") for (int k = 0; k < 2; ++k) \
        acc[ai][bj][m][n] = __builtin_amdgcn_mfma_f32_16x16x32_bf16(Bt[n][k], At[m][k], acc[ai][bj][m][n], 0, 0, 0); __builtin_amdgcn_s_setprio(0); } while (0)
#define PG8_WAIT_V(n) asm volatile("s_waitcnt vmcnt(" #n ")" ::: "memory")
#define PG8_WAIT_L(n) asm volatile("s_waitcnt lgkmcnt(" #n ")" ::: "memory")
#define PG8_BAR __builtin_amdgcn_s_barrier()
#define PG8_SCHED __builtin_amdgcn_sched_barrier(0)
    Unit cur, nxt; int ui = 0;
    if (!S.next(0, cur)) return;
    f32x4 acc[2][2][4][2];
#pragma unroll
    for (int a = 0; a < 2; ++a)
#pragma unroll
        for (int b = 0; b < 2; ++b)
#pragma unroll
            for (int m = 0; m < 4; ++m)
#pragma unroll
                for (int n = 0; n < 2; ++n) acc[a][b][m][n] = (f32x4){0.f, 0.f, 0.f, 0.f};
    bf16x8 At[4][2], B0[2][2], B1[2][2];
    const char* cA = (const char*)g.A + (size_t)cur.pm * tstep; const char* cB = (const char*)g.Bt + (size_t)cur.pn * tstep;
    S.a_ready(cur);
    if constexpr (SP2) {
        PG8_STAGE(PG8_SB(0, 0), cB, voffB); PG8_STAGE(PG8_SB(0, 1), cB + hstep, voffB); PG8_STAGE(PG8_SA(0, 0), cA, voffA); PG8_STAGE(PG8_SA(0, 1), cA + hstep, voffA);
        if (wr == 1) PG8_BAR;
        PG8_WAIT_V(2); PG8_BAR;
        PG8_STAGE(PG8_SB(1, 0), cB + kstep, voffB); PG8_STAGE(PG8_SA(1, 0), cA + kstep, voffA); PG8_STAGE(PG8_SB(1, 1), cB + hstep + kstep, voffB);
        PG8_WAIT_V(6); PG8_BAR;
    } else {
        PG8_STAGE(PG8_SB(0, 0), cB, voffB); PG8_STAGE(PG8_SA(0, 0), cA, voffA); PG8_STAGE(PG8_SB(0, 1), cB + hstep, voffB); PG8_STAGE(PG8_SA(0, 1), cA + hstep, voffA);
        if (wr == 1) PG8_BAR;
        PG8_WAIT_V(4); PG8_BAR;
        PG8_STAGE(PG8_SB(1, 0), cB + kstep, voffB); PG8_STAGE(PG8_SA(1, 0), cA + kstep, voffA); PG8_STAGE(PG8_SB(1, 1), cB + hstep + kstep, voffB);
        PG8_WAIT_V(6); PG8_BAR;
    }
    for (;;) {
        const bool has_next = S.next(ui + 1, nxt);
        const char* nA = has_next ? (const char*)g.A + (size_t)nxt.pm * tstep : cA; const char* nB = has_next ? (const char*)g.Bt + (size_t)nxt.pn * tstep : cB;
        for (int t = 0; t < nt; t += 2) {
            const bool last = (t == nt - 2);
            const char* a1 = cA + (size_t)(t + 1) * kstep;
            const char* a2 = last ? nA : cA + (size_t)(t + 2) * kstep; const char* b2 = last ? nB : cB + (size_t)(t + 2) * kstep;
            const char* a3 = a2 + kstep; const char* b3 = b2 + kstep;
            if (last && has_next) S.a_ready(nxt);
            if constexpr (SP2) {
            PG8_LDB(B0, 0, 0); PG8_LDB(B1, 0, 1); PG8_SCHED; PG8_LDA(At, 0, 0); PG8_STAGE(PG8_SA(1, 1), a1 + hstep, voffA);
            PG8_WAIT_V(8); PG8_WAIT_L(0); PG8_BAR; PG8_MMA(0, 0, At, B0); PG8_MMA(0, 1, At, B1); PG8_BAR; PG8_SCHED;
            PG8_LDA(At, 0, 1); PG8_STAGE(PG8_SB(0, 0), b2, voffB); PG8_STAGE(PG8_SB(0, 1), b2 + hstep, voffB); PG8_STAGE(PG8_SA(0, 0), a2, voffA);
            PG8_WAIT_V(8); PG8_WAIT_L(0); PG8_BAR; PG8_MMA(1, 0, At, B0); PG8_MMA(1, 1, At, B1); PG8_BAR; PG8_SCHED;
            PG8_LDB(B0, 1, 0); PG8_LDB(B1, 1, 1); PG8_SCHED; PG8_LDA(At, 1, 0); PG8_STAGE(PG8_SA(0, 1), a2 + hstep, voffA);
            PG8_WAIT_V(8); PG8_WAIT_L(0); PG8_BAR; PG8_MMA(0, 0, At, B0); PG8_MMA(0, 1, At, B1); PG8_BAR; PG8_SCHED;
            PG8_LDA(At, 1, 1); PG8_STAGE(PG8_SB(1, 0), b3, voffB); PG8_STAGE(PG8_SB(1, 1), b3 + hstep, voffB); PG8_STAGE(PG8_SA(1, 0), a3, voffA);
            PG8_WAIT_V(8); PG8_WAIT_L(0); PG8_BAR; PG8_MMA(1, 0, At, B0); PG8_MMA(1, 1, At, B1); PG8_BAR; PG8_SCHED;
            } else {
            PG8_LDB(B0, 0, 0); PG8_SCHED; PG8_LDA(At, 0, 0); PG8_STAGE(PG8_SA(1, 1), a1 + hstep, voffA);
            PG8_WAIT_L(8); PG8_BAR; PG8_WAIT_L(0); PG8_MMA(0, 0, At, B0); PG8_BAR; PG8_SCHED;
            PG8_LDB(B1, 0, 1); PG8_STAGE(PG8_SB(0, 0), b2, voffB);
            PG8_BAR; PG8_WAIT_L(0); PG8_MMA(0, 1, At, B1); PG8_BAR;
            PG8_LDA(At, 0, 1); PG8_STAGE(PG8_SA(0, 0), a2, voffA);
            PG8_BAR; PG8_WAIT_L(0); PG8_MMA(1, 0, At, B0); PG8_BAR; PG8_SCHED;
            PG8_STAGE(PG8_SB(0, 1), b2 + hstep, voffB);
            PG8_WAIT_V(6); PG8_BAR; PG8_MMA(1, 1, At, B1); PG8_BAR;
            PG8_LDB(B0, 1, 0); PG8_SCHED; PG8_LDA(At, 1, 0); PG8_STAGE(PG8_SA(0, 1), a2 + hstep, voffA);
            PG8_WAIT_L(8); PG8_BAR; PG8_WAIT_L(0); PG8_MMA(0, 0, At, B0); PG8_BAR; PG8_SCHED;
            PG8_LDB(B1, 1, 1); PG8_STAGE(PG8_SB(1, 0), b3, voffB);
            PG8_BAR; PG8_WAIT_L(0); PG8_MMA(0, 1, At, B1); PG8_BAR;
            PG8_LDA(At, 1, 1); PG8_STAGE(PG8_SA(1, 0), a3, voffA);
            PG8_BAR; PG8_WAIT_L(0); PG8_MMA(1, 0, At, B0); PG8_BAR; PG8_SCHED;
            PG8_STAGE(PG8_SB(1, 1), b3 + hstep, voffB);
            PG8_WAIT_V(6); PG8_BAR; PG8_MMA(1, 1, At, B1); PG8_BAR;
            }
        }
        if constexpr (ALIGN_EPI) { if (wr == 0) PG8_BAR; }
        if constexpr (!Epi::AFTER_DRAIN) { E(acc, cur, wr, wc, fr, fq); S.done(cur); }
        if (!has_next) break;
#pragma unroll
        for (int a = 0; a < 2; ++a)
#pragma unroll
            for (int b = 0; b < 2; ++b)
#pragma unroll
                for (int m = 0; m < 4; ++m)
#pragma unroll
                    for (int n = 0; n < 2; ++n) acc[a][b][m][n] = (f32x4){0.f, 0.f, 0.f, 0.f};
        cur = nxt; cA = nA; cB = nB; ++ui;
        if constexpr (ALIGN_EPI) { if (wr == 1) PG8_BAR; }
    }
    PG8_WAIT_V(0);
    if constexpr (!ALIGN_EPI) { if (wr == 0) PG8_BAR; }
    PG8_BAR;
    if constexpr (Epi::AFTER_DRAIN) { E.fused(acc, cur, wr, wc, fr, fq, lds, wid, lane); S.done(cur); }
#undef PG8_SA
#undef PG8_SB
#undef PG8_STAGE
#undef PG8_LDA
#undef PG8_LDB
#undef PG8_MMA
#undef PG8_WAIT_V
#undef PG8_WAIT_L
#undef PG8_BAR
#undef PG8_SCHED
}
}
namespace att {
constexpr int NW = 8, QBLK = 32, KVBLK = 64, QB = NW * QBLK, DV = 128;
constexpr int SHM_V = KVBLK * 128 * 2, SHM_K = KVBLK * 192 * 2;
constexpr int LDS_QX = 2 * SHM_V + 2 * SHM_K + NW * 64 * 4;
constexpr int LDS_BYTES = LDS_QX + NW * 4096;
constexpr float SCALE = 0.07216878364870322f;
constexpr float THR = 8.f;
#define KSWZ(row, colB) ((row) * 384 + ((colB) ^ (((row) & 7) << 4)))
#define SBAR() __builtin_amdgcn_sched_barrier(0)
__device__ __forceinline__ int v_st(int k, int c) { const int kk = (k & ~0xC) | ((k & 4) << 1) | ((k & 8) >> 1); return ((kk >> 3) * 4 + (c >> 5)) * 512 + ((kk & 7) * 32 + (c & 31)) * 2; }
__device__ __forceinline__ int v_rd_base(int lane) { return ((lane & 3) << 3) | (((lane >> 2) & 3) << 6) | (((lane >> 4) & 1) << 5) | (((lane >> 5) & 1) << 8); }
constexpr int v_rd_off(int d0, int ks, int half) { return d0 * 512 + ks * 4096 + half * 2048; }
__device__ __forceinline__ int crow(int r, int hi) { return (r & 3) + 8 * (r >> 2) + 4 * hi; }
__device__ __forceinline__ void mask_tile(f32x16& p0, f32x16& p1, int dq) {
    const float NEG = -__builtin_inff();
#pragma unroll
    for (int r = 0; r < 16; ++r) { const int c = (r & 3) + 8 * (r >> 2); if (dq - c < 0) p0[r] = NEG; if (dq - c - 32 < 0) p1[r] = NEG; }
}
__device__ __forceinline__ void partialSM(f32x16& p0, f32x16& p1, float& m_reg, float& mn, float& alpha) {
    float pmax = p0[0];
#pragma unroll
    for (int r = 1; r < 16; ++r) pmax = fmaxf(pmax, p0[r]);
#pragma unroll
    for (int r = 0; r < 16; ++r) pmax = fmaxf(pmax, p1[r]);
    { auto rr = __builtin_amdgcn_permlane32_swap(__float_as_uint(pmax), __float_as_uint(pmax), false, false);
      pmax = fmaxf(__uint_as_float(rr[0]), __uint_as_float(rr[1])); }
    constexpr float C2 = 1.4426950408889634f * SCALE;
    if (__builtin_expect(__all((pmax - m_reg) * SCALE <= THR), 1)) { mn = m_reg; alpha = 1.f; }
    else { mn = fmaxf(m_reg, pmax); alpha = __builtin_amdgcn_exp2f((m_reg - mn) * C2); m_reg = mn; }
    const float mnL = -mn * C2;
#pragma unroll
    for (int r = 0; r < 16; ++r) p0[r] = fmaf(p0[r], C2, mnL);
#pragma unroll
    for (int r = 0; r < 16; ++r) p1[r] = fmaf(p1[r], C2, mnL);
#pragma unroll
    for (int r = 0; r < 16; ++r) p0[r] = __builtin_amdgcn_exp2f(p0[r]);
}
#define PK4(P, B_, OUT) do { unsigned a0 = cvtpk(P[B_+0], P[B_+1]), a1 = cvtpk(P[B_+2], P[B_+3]);                          \
        unsigned b0 = cvtpk(P[B_+4], P[B_+5]), b1 = cvtpk(P[B_+6], P[B_+7]);                                             \
        auto r0 = __builtin_amdgcn_permlane32_swap(a0, b0, false, false); auto r1 = __builtin_amdgcn_permlane32_swap(a1, b1, false, false); \
        u32x4 w = {r0[0], r1[0], r0[1], r1[1]}; OUT = *reinterpret_cast<bf16x8*>(&w); } while (0)
__device__ __forceinline__ void finishSM(f32x16& p0, f32x16& p1, float alpha, float& l_reg, bf16x8& pa0, bf16x8& pa1, bf16x8& pa2, bf16x8& pa3) {
#pragma unroll
    for (int r = 0; r < 16; ++r) p1[r] = __builtin_amdgcn_exp2f(p1[r]);
    float ps = 0;
#pragma unroll
    for (int r = 0; r < 16; ++r) ps += p0[r];
#pragma unroll
    for (int r = 0; r < 16; ++r) ps += p1[r];
    { auto rr = __builtin_amdgcn_permlane32_swap(__float_as_uint(ps), __float_as_uint(ps), false, false);
      ps = __uint_as_float(rr[0]) + __uint_as_float(rr[1]); }
    l_reg = l_reg * alpha + ps;
    PK4(p0, 0, pa0); PK4(p0, 8, pa1); PK4(p1, 0, pa2); PK4(p1, 8, pa3);
}
template <int KB>
__device__ __forceinline__ void qkt(f32x16& p0, f32x16& p1, const char* K_lds, int r32, int hi, const bf16x8* qr, const char* qx) {
    p0 = f32x16{}; p1 = f32x16{};
    const char* kb[4];
#pragma unroll
    for (int dd = 0; dd < 4; ++dd) kb[dd] = K_lds + KB * SHM_K + KSWZ(r32, (dd * 16 + hi * 8) * 2);
#pragma unroll
    for (int d0 = 0; d0 < 12; ++d0) { const char* a = kb[d0 & 3] + (d0 >> 2) * 128;
        bf16x8 b0 = *reinterpret_cast<const bf16x8*>(a);
        bf16x8 b1 = *reinterpret_cast<const bf16x8*>(a + 32 * 384);
        const bf16x8 q = d0 < 8 ? qr[d0 & 7] : *reinterpret_cast<const bf16x8*>(qx + (d0 - 8) * 1024);
        p0 = __builtin_amdgcn_mfma_f32_32x32x16_bf16(b0, q, p0, 0, 0, 0);
        p1 = __builtin_amdgcn_mfma_f32_32x32x16_bf16(b1, q, p1, 0, 0, 0); }
}
template <int VB>
__device__ __forceinline__ void pv_tile(f32x16* o, int vb0, bf16x8 pa0, bf16x8 pa1, bf16x8 pa2, bf16x8 pa3) {
#define TRRD(dst, off) asm volatile("ds_read_b64_tr_b16 %0, %1 offset:%2" : "=&v"(dst) : "v"(vb0), "i"(off) : "memory")
#define PV_D2(da, db) do { s16x4 l0, l1, l2, l3, h0, h1, h2, h3, m0, m1, m2, m3, n0, n1, n2, n3; constexpr int b_ = VB * SHM_V + v_rd_off(da, 0, 0), c_ = VB * SHM_V + v_rd_off(db, 0, 0);   \
        TRRD(l0, b_); TRRD(h0, b_ + 2048); TRRD(m0, c_); TRRD(n0, c_ + 2048); TRRD(l1, b_ + 4096); TRRD(h1, b_ + 6144); TRRD(m1, c_ + 4096); TRRD(n1, c_ + 6144);   \
        TRRD(l2, b_ + 8192); TRRD(h2, b_ + 10240); TRRD(m2, c_ + 8192); TRRD(n2, c_ + 10240); TRRD(l3, b_ + 12288); TRRD(h3, b_ + 14336); TRRD(m3, c_ + 12288); TRRD(n3, c_ + 14336);   \
        asm volatile("s_waitcnt lgkmcnt(0)" ::: "memory"); SBAR();     \
        o[da] = __builtin_amdgcn_mfma_f32_32x32x16_bf16(pa0, (bf16x8){l0[0], l0[1], l0[2], l0[3], h0[0], h0[1], h0[2], h0[3]}, o[da], 0, 0, 0);   \
        o[db] = __builtin_amdgcn_mfma_f32_32x32x16_bf16(pa0, (bf16x8){m0[0], m0[1], m0[2], m0[3], n0[0], n0[1], n0[2], n0[3]}, o[db], 0, 0, 0);   \
        o[da] = __builtin_amdgcn_mfma_f32_32x32x16_bf16(pa1, (bf16x8){l1[0], l1[1], l1[2], l1[3], h1[0], h1[1], h1[2], h1[3]}, o[da], 0, 0, 0);   \
        o[db] = __builtin_amdgcn_mfma_f32_32x32x16_bf16(pa1, (bf16x8){m1[0], m1[1], m1[2], m1[3], n1[0], n1[1], n1[2], n1[3]}, o[db], 0, 0, 0);   \
        o[da] = __builtin_amdgcn_mfma_f32_32x32x16_bf16(pa2, (bf16x8){l2[0], l2[1], l2[2], l2[3], h2[0], h2[1], h2[2], h2[3]}, o[da], 0, 0, 0);   \
        o[db] = __builtin_amdgcn_mfma_f32_32x32x16_bf16(pa2, (bf16x8){m2[0], m2[1], m2[2], m2[3], n2[0], n2[1], n2[2], n2[3]}, o[db], 0, 0, 0);   \
        o[da] = __builtin_amdgcn_mfma_f32_32x32x16_bf16(pa3, (bf16x8){l3[0], l3[1], l3[2], l3[3], h3[0], h3[1], h3[2], h3[3]}, o[da], 0, 0, 0);   \
        o[db] = __builtin_amdgcn_mfma_f32_32x32x16_bf16(pa3, (bf16x8){m3[0], m3[1], m3[2], m3[3], n3[0], n3[1], n3[2], n3[3]}, o[db], 0, 0, 0); } while (0)
    PV_D2(0, 1); PV_D2(2, 3);
#undef PV_D2
#undef TRRD
}
struct BlockRef { const bf16_t* QN; const bf16_t* QR; const bf16_t* KN; const bf16_t* KR; const bf16_t* V; const bf16_t* G; bf16_t* O; int P0; };
struct Seam { bf16x8 qr[8]; bf16x8 st_v0, st_v1, st_k0, st_k1, st_k2; };
#define VMW() asm volatile("s_waitcnt vmcnt(0)" ::: "memory")
#define VMWN(n) asm volatile("s_waitcnt vmcnt(%0)" :: "i"(n) : "memory")
#define SLOAD_H(R, k0) do { const bf16_t* Vp_ = (R).V + (size_t)(k0) * 2048; const bf16_t* Kp_ = (R).KN + (size_t)(k0) * 2048; const bf16_t* Rp_ = (R).KR + (size_t)(k0) * 64;  \
                            S.st_v0 = *(const bf16x8*)(Vp_ + voff); S.st_v1 = *(const bf16x8*)(Vp_ + 32 * 2048 + voff);    \
                            S.st_k0 = *(const bf16x8*)(Kp_ + voff); S.st_k1 = *(const bf16x8*)(Kp_ + 32 * 2048 + voff);  \
                            S.st_k2 = *(const bf16x8*)(Rp_ + roff); } while (0)
#define SWRITE_HK(bf) do { *(bf16x8*)(K_lds + (bf) * SHM_K + kws) = S.st_k0; *(bf16x8*)(K_lds + (bf) * SHM_K + kws + 32 * 384) = S.st_k1; *(bf16x8*)(K_lds + (bf) * SHM_K + kws2) = S.st_k2; } while (0)
#define SWRITE_HV(bf) do { *(bf16x8*)(V_lds + (bf) * SHM_V + vst0) = S.st_v0; *(bf16x8*)(V_lds + (bf) * SHM_V + vst1) = S.st_v1; } while (0)
#define SWRITE_H(bf) do { SWRITE_HV(bf); SWRITE_HK(bf); } while (0)
#define QLOAD(R) do { _Pragma("unroll") for (int d0 = 0; d0 < 8; ++d0) S.qr[d0] = *(const bf16x8*)((R).QN + d0 * 16 + qoff); } while (0)
__device__ __forceinline__ void attn_prime(const BlockRef& cur, char* lds, Seam& S) {
    const int tid = threadIdx.x, wid = __builtin_amdgcn_readfirstlane(tid >> 6), lane = tid & 63, r32 = lane & 31, hi = lane >> 5;
    const int sr = tid >> 4, sc = (tid & 15) * 8, rr = tid >> 3, rc = (tid & 7) * 8, kws = KSWZ(sr, sc * 2), kws2 = KSWZ(rr, (128 + rc) * 2); char* K_lds = lds;
    const unsigned voff = (unsigned)(sr * 2048 + sc), roff = (unsigned)(rr * 64 + rc), qoff = (unsigned)((wid * QBLK + r32) * 2048 + hi * 8);
    QLOAD(cur);
    SLOAD_H(cur, 0); VMW(); SWRITE_HK(0);
    __syncthreads();
}
__device__ __forceinline__ void attn_block(const BlockRef& cur, const BlockRef& nxt, char* lds, Seam& S) {
    const int tid = threadIdx.x, wid = __builtin_amdgcn_readfirstlane(tid >> 6), lane = tid & 63, r32 = lane & 31, hi = lane >> 5;
    const int NT = (cur.P0 + QB) / KVBLK;
    const int qlo = cur.P0 + wid * QBLK, qm = qlo + r32 - 4 * hi;
    char* K_lds = lds; char* V_lds = lds + 2 * SHM_K;
    float* ws = (float*)(lds + 2 * SHM_V + 2 * SHM_K) + wid * 64; float* li_l = ws, * al_l = ws + 32;
    char* qx = lds + LDS_QX + wid * 4096 + lane * 16;
    { bf16x8 t4[4];
#pragma unroll
      for (int d0 = 0; d0 < 4; ++d0) t4[d0] = *(const bf16x8*)(cur.QR + d0 * 16 + (unsigned)((wid * QBLK + r32) * 1024 + hi * 8));
#pragma unroll
      for (int d0 = 0; d0 < 4; ++d0) *(bf16x8*)(qx + d0 * 1024) = t4[d0]; }
    float m_reg = -1e30f, l_reg = 0; f32x16 o[4] = {};
    const int sr = tid >> 4, sc = (tid & 15) * 8, rr = tid >> 3, rc = (tid & 7) * 8;
    const unsigned voff = (unsigned)(sr * 2048 + sc), roff = (unsigned)(rr * 64 + rc), qoff = (unsigned)((wid * QBLK + r32) * 2048 + hi * 8);
    const int vst0 = v_st(sr, sc), vst1 = v_st(32 + sr, sc), kws = KSWZ(sr, sc * 2), kws2 = KSWZ(rr, (128 + rc) * 2);
    const int vb0 = (int)(uintptr_t)V_lds + v_rd_base(lane);
#define RESC(a) do { if (__any((a) < 1.f)) { if (hi == 0) al_l[r32] = (a); asm volatile("s_waitcnt lgkmcnt(0)" ::: "memory");              \
                     _Pragma("unroll") for (int d_ = 0; d_ < 4; ++d_) _Pragma("unroll") for (int r = 0; r < 16; ++r) o[d_][r] *= al_l[crow(r, hi)]; } } while (0)
#define KBASE(t) ((t) * KVBLK)
#define MASKT(P0_, P1_, t) do { const int kb_ = KBASE(t); if (kb_ + KVBLK - 1 > qlo) mask_tile(P0_, P1_, qm - kb_); } while (0)
#define SEAM_K0() do { VMWN(8); SWRITE_HK(0); SBAR(); } while (0)
    f32x16 pA0, pA1, pB0, pB1; float mnA, mnB, alA, alB; bf16x8 pa0, pa1, pa2, pa3;
    SWRITE_HV(0); SBAR();
    if (NT > 1) SLOAD_H(cur, KBASE(1));
    SBAR(); qkt<0>(pA0, pA1, K_lds, r32, hi, S.qr, qx);
    MASKT(pA0, pA1, 0); partialSM(pA0, pA1, m_reg, mnA, alA);
    if (NT > 1) { VMW(); SWRITE_H(1); }
    __syncthreads();
#define HALF_STEP(PX0, PX1, mnX, alX, PY0, PY1, alY, t, KB, VB, SB) do {                                                      \
        SBAR(); qkt<KB>(PX0, PX1, K_lds, r32, hi, S.qr, qx);                                                                      \
        finishSM(PY0, PY1, alY, l_reg, pa0, pa1, pa2, pa3); SBAR();                                                           \
        if ((t) + 1 < NT) { SLOAD_H(cur, KBASE((t) + 1)); SBAR(); }                                                           \
        pv_tile<VB>(o, vb0, pa0, pa1, pa2, pa3); MASKT(PX0, PX1, (t)); partialSM(PX0, PX1, m_reg, mnX, alX);                  \
        __syncthreads();                                                                                                      \
        if ((t) + 1 < NT) { VMW(); SWRITE_H(SB); }                                                                            \
        RESC(alX); __syncthreads(); } while (0)
    for (int t = 1; t + 1 < NT; t += 2) {
        HALF_STEP(pB0, pB1, mnB, alB, pA0, pA1, alA, t, 1, 0, 0);
        HALF_STEP(pA0, pA1, mnA, alA, pB0, pB1, alB, t + 1, 0, 1, 1);
    }
    SBAR(); qkt<1>(pB0, pB1, K_lds, r32, hi, S.qr, qx); SBAR();
    finishSM(pA0, pA1, alA, l_reg, pa0, pa1, pa2, pa3); SBAR();
    pv_tile<0>(o, vb0, pa0, pa1, pa2, pa3);
    SBAR(); SLOAD_H(nxt, 0); SBAR();
    MASKT(pB0, pB1, NT - 1); partialSM(pB0, pB1, m_reg, mnB, alB); __syncthreads(); RESC(alB);
    finishSM(pB0, pB1, alB, l_reg, pa0, pa1, pa2, pa3); SBAR(); pv_tile<1>(o, vb0, pa0, pa1, pa2, pa3);
    SBAR(); QLOAD(nxt); SBAR();
    SEAM_K0();
    if (hi == 0) li_l[r32] = l_reg; asm volatile("s_waitcnt lgkmcnt(0)" ::: "memory");
    float rli[16];
#pragma unroll
    for (int r = 0; r < 16; ++r) rli[r] = __builtin_amdgcn_rcpf(li_l[crow(r, hi)]);
    const int odd = r32 & 1;
    unsigned ob0 = (unsigned)((wid * QBLK + 4 * hi + odd) * 2048 + (r32 & ~1)) * 2u; asm volatile("" : "+v"(ob0));
    unsigned gpv[8][4];
#pragma unroll
    for (int r = 0; r < 16; r += 2)
#pragma unroll
        for (int d0 = 0; d0 < 4; ++d0) gpv[r >> 1][d0] = *(const unsigned*)((const char*)cur.G + (ob0 + (unsigned)(((r & 3) + 8 * (r >> 2)) * 4096 + d0 * 64)));
#pragma unroll
    for (int r = 0; r < 16; r += 2) {
#pragma unroll
        for (int d0 = 0; d0 < 4; ++d0) { const float a = o[d0][r] * rli[r], b = o[d0][r + 1] * rli[r + 1];
            const float rv = __shfl_xor(odd ? a : b, 1);
            const unsigned bo = ob0 + (unsigned)(((r & 3) + 8 * (r >> 2)) * 4096 + d0 * 64);
            const unsigned gp = gpv[r >> 1][d0];
            const float lo = (odd ? rv : a) * bflo(gp), hv = (odd ? b : rv) * bfhi(gp);
            *(unsigned*)((char*)cur.O + bo) = cvtpk(lo, hv); } }
    __syncthreads();
#undef RESC
#undef KBASE
#undef MASKT
#undef SEAM_K0
#undef HALF_STEP
}
#undef VMW
#undef VMWN
#undef SLOAD_H
#undef SWRITE_HK
#undef SWRITE_HV
#undef SWRITE_H
#undef QLOAD
struct Tensors { const bf16_t* QN; const bf16_t* QR; const bf16_t* KN; const bf16_t* KR; const bf16_t* V; const bf16_t* G; bf16_t* O; };
__device__ __forceinline__ BlockRef mkref(const Tensors& Tn, int bh, int qb) {
    const int b = bh >> 4, h = bh & 15; const size_t r0 = (size_t)b * SEQ, rq = r0 + (size_t)qb * QB; BlockRef r;
    r.QN = Tn.QN + rq * 2048 + h * 128; r.QR = Tn.QR + rq * 1024 + h * 64; r.KN = Tn.KN + r0 * 2048 + h * 128; r.KR = Tn.KR + r0 * 64; r.V = Tn.V + r0 * 2048 + h * 128;
    r.G = Tn.G + rq * 2048 + h * 128; r.O = Tn.O + rq * 2048 + h * 128; r.P0 = qb * QB; return r;
}
__device__ __forceinline__ void attn_phase(char* lds, const Tensors& Tn) {
    constexpr int NQB = SEQ / QB, NX = NQB / 2, TOTAL = NX * BATCH * MLA_H;
    const int stride = gridDim.x; int L = (stride % 8 == 0) ? (int)(blockIdx.x % 8) * (stride / 8) + (int)(blockIdx.x / 8) : (int)blockIdx.x; if (L >= TOTAL) return;
    int pass = 0; int bh = L / NX, y = L % NX;
    BlockRef cur = mkref(Tn, bh, y);
    Seam S;
    attn_prime(cur, lds, S);
    for (;;) {
        const bool more_pass = pass == 0, more_item = L + stride < TOTAL, last = !more_pass && !more_item;
        int passn = pass + 1, Ln = L, bhn = bh, yn = y;
        if (!more_pass) { passn = 0; Ln = more_item ? L + stride : L; bhn = Ln / NX; yn = Ln % NX; }
        const BlockRef nxt = last ? cur : mkref(Tn, bhn, passn ? NQB - 1 - yn : yn);
        attn_block(cur, nxt, lds, S);
        if (last) break;
        cur = nxt; pass = passn; L = Ln; bh = bhn; y = yn;
    }
}
#undef KSWZ
#undef SBAR
#undef PK4
}

namespace ret {
constexpr int PK = 544, PKP = 528, PV = 144, PS = 528;
constexpr int OFF_K = 0, OFF_V = 128 * PK, OFF_S = OFF_V + 128 * PV, LDS_BYTES = OFF_S + 64 * PS;
__device__ __forceinline__ int crow(int r, int hi) { return (r & 3) + 8 * (r >> 2) + 4 * hi; }
typedef short v4i16_t __attribute__((ext_vector_type(4)));
__device__ __forceinline__ s16x4 trd(LAS const char* p) { return __builtin_bit_cast(s16x4, __builtin_amdgcn_ds_read_tr16_b64_v4i16((LAS v4i16_t*)p)); }
__device__ __forceinline__ bf16x8 tr8(LAS const char* p, int pitch) { const s16x4 a = trd(p), b = trd(p + 4 * pitch); return (bf16x8){a[0], a[1], a[2], a[3], b[0], b[1], b[2], b[3]}; }
#define PK4R(P, B_, OUT) do { unsigned a0 = cvtpk(P[B_+0], P[B_+1]), a1 = cvtpk(P[B_+2], P[B_+3]);                          \
        unsigned b0 = cvtpk(P[B_+4], P[B_+5]), b1 = cvtpk(P[B_+6], P[B_+7]);                                             \
        auto r0 = __builtin_amdgcn_permlane32_swap(a0, b0, false, false); auto r1 = __builtin_amdgcn_permlane32_swap(a1, b1, false, false); \
        u32x4 w = {r0[0], r1[0], r0[1], r1[1]}; OUT = *reinterpret_cast<bf16x8*>(&w); } while (0)
__device__ __forceinline__ void retp_phase(LAS char* lds, const bf16_t* Qg, bf16_t* Kg, bf16x8* Pf) {
    const int tid = threadIdx.x, w = __builtin_amdgcn_readfirstlane(tid >> 6), lane = tid & 63, r32 = lane & 31, hi = lane >> 5;
    const int nb = w & 3, half = w >> 2;
    LAS char* Ks = lds + OFF_K;
    const int trKP = (8 * (lane >> 5) + ((lane & 15) >> 2)) * PKP + (16 * ((lane >> 4) & 1) + 4 * (lane & 3)) * 2;
    LAS char* Qs = lds + OFF_K + 128 * PKP;
    bf16x8 stk[8], stq[8];
    int it = blockIdx.x;
    if (it < 2048) {
        const bf16_t* kb_ = Kg + ((size_t)(it >> 6) / 8 * SEQ + (size_t)(it & 63) * 128) * 2048 + ((it >> 6) & 7) * 256;
#pragma unroll
        for (int i = 0; i < 8; ++i) stk[i] = *(const bf16x8*)(kb_ + (size_t)((tid >> 5) + 16 * i) * 2048 + (tid & 31) * 8);
        const bf16_t* qf_ = Qg + (kb_ - Kg);
#pragma unroll
        for (int i = 0; i < 8; ++i) stq[i] = *(const bf16x8*)(qf_ + (size_t)((tid >> 5) + 16 * i) * 2048 + (tid & 31) * 8);
    }
    for (; it < 2048; it += gridDim.x) {
        const int bh = it >> 6, ci = it & 63, b = bh >> 3, h = bh & 7;
#pragma unroll
        for (int i = 0; i < 8; ++i) { *(LAS bf16x8*)(Ks + ((tid >> 5) + 16 * i) * PKP + (tid & 31) * 16) = stk[i]; *(LAS bf16x8*)(Qs + ((tid >> 5) + 16 * i) * PKP + (tid & 31) * 16) = stq[i]; }
        __syncthreads();
        bf16x8 qr[16];
#pragma unroll
        for (int s = 0; s < 16; ++s) qr[s] = *(LAS const bf16x8*)(Qs + (32 * nb + r32) * PKP + 16 * hi + 32 * s);
        { const int itn = it + (int)gridDim.x < 2048 ? it + (int)gridDim.x : it;
          const bf16_t* kn_ = Kg + ((size_t)(itn >> 6) / 8 * SEQ + (size_t)(itn & 63) * 128) * 2048 + ((itn >> 6) & 7) * 256;
#pragma unroll
          for (int i = 0; i < 8; ++i) stk[i] = *(const bf16x8*)(kn_ + (size_t)((tid >> 5) + 16 * i) * 2048 + (tid & 31) * 8);
          const bf16_t* qn_ = Qg + (kn_ - Kg);
#pragma unroll
          for (int i = 0; i < 8; ++i) stq[i] = *(const bf16x8*)(qn_ + (size_t)((tid >> 5) + 16 * i) * 2048 + (tid & 31) * 8); }
        for (int mt = half; mt <= nb; mt += 2) {
            f32x16 p = {}, p2 = {};
            LAS const char* kp = Ks + (32 * mt + r32) * PKP + 16 * hi;
#pragma unroll
            for (int s = 0; s < 16; s += 2) { const bf16x8 afr = *(LAS const bf16x8*)(kp + 32 * s), afr2 = *(LAS const bf16x8*)(kp + 32 * s + 32);
                p = __builtin_amdgcn_mfma_f32_32x32x16_bf16(afr, qr[s], p, 0, 0, 0); p2 = __builtin_amdgcn_mfma_f32_32x32x16_bf16(afr2, qr[s + 1], p2, 0, 0, 0); }
#pragma unroll
            for (int r = 0; r < 16; ++r) p[r] += p2[r];
            if (mt == nb) {
#pragma unroll
                for (int r = 0; r < 16; ++r) if (crow(r, hi) > r32) p[r] = 0.f;
            }
            bf16x8 pa0, pa1; PK4R(p, 0, pa0); PK4R(p, 8, pa1);
            bf16x8* dst = Pf + ((size_t)(it * 10 + nb * (nb + 1) / 2 + mt) * 2) * 64 + lane;
            dst[0] = pa0; dst[64] = pa1;
        }
        __builtin_amdgcn_sched_barrier(0);
        { bf16_t* kw_ = Kg + ((size_t)b * SEQ + (size_t)ci * 128) * 2048 + h * 256 + (size_t)(16 * w + hi) * 2048 + r32 * 8;
#pragma unroll
          for (int ks = 0; ks < 8; ++ks) { const bf16x8 af = tr8(Ks + trKP + (32 * w) * 2 + 16 * ks * PKP, PKP); *(bf16x8*)(kw_ + (size_t)ks * 2 * 2048) = af; } }
        __syncthreads();
    }
}
constexpr int PQ = 528, SOFF_V = 0, SOFF_S = 128 * PV, SOFF_Q = SOFF_S + 64 * PS, SCAN_LDS = SOFF_Q + 128 * PQ;
__device__ __forceinline__ void ret_phase(LAS char* lds, const bf16_t* Qg, const bf16_t* Kg, const bf16_t* Vg, bf16_t* Og, const bf16x8* Pf) {
    const int tid = threadIdx.x, w = __builtin_amdgcn_readfirstlane(tid >> 6), lane = tid & 63, r32 = lane & 31, hi = lane >> 5;
    const int nb = (w < 4) ? w : 7 - w, vh = w >> 2;
    const int trh = lane >> 5, trblk = (lane >> 4) & 1, trq = (lane & 15) >> 2, trp = lane & 3;
    const int trV = (8 * trh + trq) * PV + (16 * trblk + 4 * trp) * 2;
    for (int it = blockIdx.x; it < 256; it += gridDim.x) {
        const int bh = (it & 7) * 4 + (it >> 6), vs = (it >> 3) & 7, b = bh >> 3, h = bh & 7;
        const size_t rowbase = (size_t)b * SEQ;
        const bf16_t* qb_ = Qg + rowbase * 2048 + h * 256; const unsigned qo = (unsigned)((tid >> 5) * 2048 + (tid & 31) * 8);
        const bf16_t* kf_ = Kg + rowbase * 2048 + h * 256; const unsigned ko = (unsigned)((16 * w + hi) * 2048 + r32 * 8);
        const bf16_t* vb_ = Vg + rowbase * 4096 + h * 512 + vs * 64; bf16_t* ob_ = Og + rowbase * 4096 + h * 512 + vs * 64;
        const unsigned vo0 = (unsigned)((tid >> 3) * 4096 + (tid & 7) * 8);
        const bf16x8* pfb = Pf + ((size_t)(bh * 64) * 10 + nb * (nb + 1) / 2) * 128; const unsigned po = (unsigned)lane;
        const float g128 = exp2f(128.0f * __log2f(1.0f - exp2f(-5.0f - (float)h)));
        f32x16 U0 = {}, U1 = {};
        bf16x8 stq[8], ka[8], stv[2], pf[8];
        stv[0] = *(const bf16x8*)(vb_ + vo0); stv[1] = *(const bf16x8*)(vb_ + 64 * 4096 + vo0);
#pragma unroll
        for (int i = 0; i < 8; ++i) stq[i] = *(const bf16x8*)(qb_ + i * 16 * 2048 + qo);
#pragma unroll
        for (int mt = 0; mt < 4; ++mt) { const int mc = mt <= nb ? mt : nb; pf[2 * mt] = (pfb + mc * 128)[po]; pf[2 * mt + 1] = (pfb + mc * 128 + 64)[po]; }
#pragma unroll
        for (int ks = 0; ks < 8; ++ks) ka[ks] = *(const bf16x8*)(kf_ + ks * 2 * 2048 + ko);
#pragma unroll
        for (int i = 0; i < 2; ++i) { const int c = tid + 512 * i; *(LAS bf16x8*)(lds + SOFF_V + (c >> 3) * PV + (c & 7) * 16) = stv[i]; }
#pragma unroll
        for (int g = 0; g < 4; ++g) { const u32x2 z = {0u, 0u};
            *(LAS u32x2*)(lds + SOFF_S + r32 * PS + (32 * w + 8 * g + 4 * hi) * 2) = z; *(LAS u32x2*)(lds + SOFF_S + (32 + r32) * PS + (32 * w + 8 * g + 4 * hi) * 2) = z; }
#pragma unroll
        for (int i = 0; i < 8; ++i) *(LAS bf16x8*)(lds + SOFF_Q + ((tid >> 5) + 16 * i) * PQ + (tid & 31) * 16) = stq[i];
        __syncthreads();
        LAS char* Vs = lds + SOFF_V; LAS char* Ss = lds + SOFF_S; LAS char* Qs = lds + SOFF_Q;
        for (int ci = 0; ci < 64; ++ci) {
            const size_t cn = ci + 1 < 64 ? ci + 1 : 63;
            { const bf16_t* vn_ = vb_ + cn * (128 * 4096); stv[0] = *(const bf16x8*)(vn_ + vo0); stv[1] = *(const bf16x8*)(vn_ + 64 * 4096 + vo0); }
#pragma unroll
            for (int i = 0; i < 8; ++i) stq[i] = *(const bf16x8*)(qb_ + cn * (128 * 2048) + i * 16 * 2048 + qo);
            f32x16 o = {}, o2 = {};
            { LAS const char* sp = Ss + (32 * vh + r32) * PS + 16 * hi; LAS const char* qp = Qs + (32 * nb + r32) * PQ + 16 * hi;
#pragma unroll
              for (int s = 0; s < 16; s += 2) { const bf16x8 afr = *(LAS const bf16x8*)(qp + 32 * s), bfr = *(LAS const bf16x8*)(sp + 32 * s), afr2 = *(LAS const bf16x8*)(qp + 32 * s + 32), bfr2 = *(LAS const bf16x8*)(sp + 32 * s + 32);
                  o = __builtin_amdgcn_mfma_f32_32x32x16_bf16(afr, bfr, o, 0, 0, 0); o2 = __builtin_amdgcn_mfma_f32_32x32x16_bf16(afr2, bfr2, o2, 0, 0, 0); }
#pragma unroll
              for (int r = 0; r < 16; ++r) o[r] += o2[r]; }
#pragma unroll
            for (int mt = 0; mt < 4; ++mt) if (mt <= nb) {
                LAS const char* vp = Vs + trV + (32 * mt) * PV + (32 * vh) * 2;
                const bf16x8 v0 = tr8(vp, PV), v1 = tr8(vp + 16 * PV, PV);
                o = __builtin_amdgcn_mfma_f32_32x32x16_bf16(pf[2 * mt], v0, o, 0, 0, 0);
                o = __builtin_amdgcn_mfma_f32_32x32x16_bf16(pf[2 * mt + 1], v1, o, 0, 0, 0);
            }
            { const int odd = r32 & 1; bf16_t* oc = ob_ + (size_t)ci * (128 * 4096);
              const unsigned oo = (unsigned)((32 * nb + 4 * hi + odd) * 4096 + 32 * vh + (r32 & ~1));
#pragma unroll
              for (int r = 0; r < 16; r += 2) { const float a = o[r], b = o[r + 1]; const float rv = __shfl_xor(odd ? a : b, 1);
                  const unsigned wv = cvtpk(odd ? rv : a, odd ? b : rv);
                  *(unsigned*)(oc + ((r & 3) + 8 * (r >> 2)) * 4096 + oo) = wv; } }
            { LAS const char* va = Vs + trV;
#pragma unroll
              for (int ks = 0; ks < 8; ++ks) {
                  const bf16x8 b0 = tr8(va + 16 * ks * PV, PV), b1 = tr8(va + 16 * ks * PV + 64, PV);
                  U0 = __builtin_amdgcn_mfma_f32_32x32x16_bf16(ka[ks], b0, U0, 0, 0, 0);
                  U1 = __builtin_amdgcn_mfma_f32_32x32x16_bf16(ka[ks], b1, U1, 0, 0, 0); } }
#pragma unroll
            for (int ks = 0; ks < 8; ++ks) ka[ks] = *(const bf16x8*)(kf_ + cn * (128 * 2048) + ks * 2 * 2048 + ko);
#pragma unroll
            for (int mt = 0; mt < 4; ++mt) { const int mc = mt <= nb ? mt : nb; pf[2 * mt] = (pfb + cn * 1280 + mc * 128)[po]; pf[2 * mt + 1] = (pfb + cn * 1280 + mc * 128 + 64)[po]; }
#pragma unroll
            for (int r = 0; r < 16; ++r) { U0[r] *= g128; U1[r] *= g128; }
            __syncthreads();
#pragma unroll
            for (int i = 0; i < 2; ++i) { const int c = tid + 512 * i; *(LAS bf16x8*)(Vs + (c >> 3) * PV + (c & 7) * 16) = stv[i]; }
#pragma unroll
            for (int i = 0; i < 8; ++i) *(LAS bf16x8*)(Qs + ((tid >> 5) + 16 * i) * PQ + (tid & 31) * 16) = stq[i];
#pragma unroll
            for (int g = 0; g < 4; ++g) {
                u32x2 a; a.x = cvtpk(U0[4 * g], U0[4 * g + 1]); a.y = cvtpk(U0[4 * g + 2], U0[4 * g + 3]);
                *(LAS u32x2*)(Ss + r32 * PS + (32 * w + 8 * g + 4 * hi) * 2) = a;
                u32x2 c; c.x = cvtpk(U1[4 * g], U1[4 * g + 1]); c.y = cvtpk(U1[4 * g + 2], U1[4 * g + 3]);
                *(LAS u32x2*)(Ss + (32 + r32) * PS + (32 * w + 8 * g + 4 * hi) * 2) = c;
            }
            __syncthreads();
        }
    }
}
#undef PK4R
}

constexpr int NWAVES = 8, NTHREADS = 512, LDS_BYTES = 147456;
struct Args { const float* x; const float* c; const int* pos; const float* ada_w; const float* ada_b; const float* norm_g; const float* ret_w_in; const float* ret_gn_g; const float* ret_w_out;
              const float* mla_w_in; const float* mla_qn_g; const float* mla_w_uq; const float* mla_kvn_g; const float* mla_w_ukv; const float* mla_w_out; const float* final_g;
              float* out; unsigned char* ws; int ph_lo, ph_hi, li, pad; };

__device__ __forceinline__ int rp8(int p) { return 4 * (p >> 3) + (p & 3); }
__device__ __forceinline__ int srccol(int map, int n) {
    if (map == 1) { if (n >= 4096) return n; const int p = n & 255; return (n & ~255) + rp8(p) + 128 * ((p >> 2) & 1); }
    if (map == 2) { if (n < 1024) return n; if (n < 3072) return n + 64; if (n < 3136) { const int p = n - 3072; return 1024 + rp8(p) + 32 * ((p >> 2) & 1); } return -1; }
    if (map == 3) { if (n < 2048) return (n >> 7) * 192 + (n & 127); const int m = n - 2048, p = m & 63; return (m >> 6) * 192 + 128 + rp8(p) + 32 * ((p >> 2) & 1); }
    if (map == 4) { if (n < 2048) return (n >> 7) * 256 + (n & 127); const int m = n - 2048; return (m >> 7) * 256 + 128 + (m & 127); }
    return n;
}
__device__ __forceinline__ void transpose_item(const float* W, int K, int Nsrc, bf16_t* WT, int map, const float* kscale, LAS float* scr, int kb, int nb, int lane) {
    const int k0 = 64 * kb, n0 = 32 * nb, sc = srccol(map, n0 + (lane & 31));
    float tv[32]; const int scc = sc >= 0 ? sc : 0;
#pragma unroll
    for (int i = 0; i < 32; ++i) tv[i] = W[(size_t)(k0 + 2 * i + (lane >> 5)) * Nsrc + scc];
#pragma unroll
    for (int i = 0; i < 32; ++i) { const int kk = 2 * i + (lane >> 5); float v = sc >= 0 ? tv[i] : 0.f; if (kscale) v *= kscale[k0 + kk]; scr[kk * 33 + (lane & 31)] = v; }
    asm volatile("s_waitcnt lgkmcnt(0)" ::: "memory");
    const int c = lane & 7;
#pragma unroll
    for (int j = 0; j < 4; ++j) { const int n = (lane >> 3) + 8 * j; const LAS float* s = scr + (8 * c) * 33 + n;
        u32x4 o; o.x = cvtpk(s[0 * 33], s[1 * 33]); o.y = cvtpk(s[2 * 33], s[3 * 33]); o.z = cvtpk(s[4 * 33], s[5 * 33]); o.w = cvtpk(s[6 * 33], s[7 * 33]);
        *(u32x4*)(WT + (size_t)(n0 + n) * K + k0 + 8 * c) = o; }
    asm volatile("s_waitcnt lgkmcnt(0)" ::: "memory");
}
__device__ __forceinline__ void prologue(const Args& a, LAS unsigned char* lds) {
    const int tid = threadIdx.x, lane = tid & 63, wave = __builtin_amdgcn_readfirstlane(tid >> 6), G = gridDim.x;
    unsigned char* ws = a.ws;
    float* mod = (float*)(ws + WS_CTL + CTL_MOD); float* ssq = (float*)(ws + WS_CTL + CTL_SSQQ);
    for (int i = blockIdx.x * NTHREADS + tid; i < 2 * T; i += G * NTHREADS) ssq[i] = 0.f;
    LAS float* ca = (LAS float*)lds; LAS float* red = (LAS float*)(lds + 32768);
    if (blockIdx.x < 192) {
        for (int i = tid; i < 4 * DM; i += NTHREADS) ca[i] = silu_f(a.c[i]);
        __syncthreads();
        for (int item = blockIdx.x; item < 192; item += G) {
            const int l = item / 96, cb = item % 96, c4 = tid & 15, kp = tid >> 4, col = cb * 64 + c4 * 4;
            const float* W = a.ada_w + (size_t)l * DM * 6144 + col;
            f32x4 acc0 = {0.f, 0.f, 0.f, 0.f}, acc1 = acc0, acc2 = acc0, acc3 = acc0;
#pragma unroll 8
            for (int k = kp * 64; k < kp * 64 + 64; ++k) { const f32x4 wv = *(const f32x4*)(W + (size_t)k * 6144); acc0 += wv * ca[k]; acc1 += wv * ca[2048 + k]; acc2 += wv * ca[4096 + k]; acc3 += wv * ca[6144 + k]; }
            *(LAS f32x4*)(red + ((kp * 4 + 0) * 64 + c4 * 4)) = acc0; *(LAS f32x4*)(red + ((kp * 4 + 1) * 64 + c4 * 4)) = acc1;
            *(LAS f32x4*)(red + ((kp * 4 + 2) * 64 + c4 * 4)) = acc2; *(LAS f32x4*)(red + ((kp * 4 + 3) * 64 + c4 * 4)) = acc3;
            __syncthreads();
            if (tid < 256) { const int b = tid >> 6, cl = tid & 63; float s = a.ada_b[l * 6144 + cb * 64 + cl];
#pragma unroll 8
                for (int q = 0; q < 32; ++q) s += red[(q * 4 + b) * 64 + cl];
                mod[(size_t)(l * 4 + b) * 6144 + cb * 64 + cl] = s; }
            __syncthreads();
        }
    }
    LAS float* scr = (LAS float*)(lds + 65536 + wave * 8704);
    const int gw = blockIdx.x * NWAVES + wave, NGW = G * NWAVES;
    constexpr int I0 = 32 * 384, I1 = 64 * 64, I2 = 32 * 104, I3 = 8 * 96, I4 = 8 * 128, I5 = 32 * 64, NIT = I0 + I1 + I2 + I3 + I4 + I5;
    for (int it = gw; it < NIT; it += NGW) {
        int r = it;
        if (r < I0) { transpose_item(a.ret_w_in, 2048, RET_IN, (bf16_t*)(ws + WS_WRIN), 1, nullptr, scr, r / 384, r % 384, lane); continue; } r -= I0;
        if (r < I1) { transpose_item(a.ret_w_out, 4096, 2048, (bf16_t*)(ws + WS_WROUT), 0, a.ret_gn_g, scr, r / 64, r % 64, lane); continue; } r -= I1;
        if (r < I2) { transpose_item(a.mla_w_in, 2048, MLA_IN, (bf16_t*)(ws + WS_WMIN), 2, nullptr, scr, r / 104, r % 104, lane); continue; } r -= I2;
        if (r < I3) { transpose_item(a.mla_w_uq, 512, 3072, (bf16_t*)(ws + WS_WUQ), 3, a.mla_qn_g, scr, r / 96, r % 96, lane); continue; } r -= I3;
        if (r < I4) { transpose_item(a.mla_w_ukv, 512, 4096, (bf16_t*)(ws + WS_WUKV), 4, a.mla_kvn_g, scr, r / 128, r % 128, lane); continue; } r -= I4;
        transpose_item(a.mla_w_out, 2048, 2048, (bf16_t*)(ws + WS_WMOUT), 0, nullptr, scr, r / 64, r % 64, lane);
    }
}
__device__ __forceinline__ void norm_mod_pass(const float* xin, const float* g, const float* modl, bf16_t* H) {
    int tid = threadIdx.x; asm volatile("" : "+v"(tid));
    const int  lane = tid & 63, wave = tid >> 6, gw = blockIdx.x * NWAVES + wave, NGW = gridDim.x * NWAVES;
    for (int r0 = gw * 16; r0 < T; r0 += NGW * 16) {
        const float* mb = modl + (size_t)(r0 / SEQ) * 6144;
        f32x4 A[8], Bv[8];
#pragma unroll
        for (int j = 0; j < 8; ++j) { const int c = 4 * (64 * j + lane); const f32x4 gg = *(const f32x4*)(g + c), sc = *(const f32x4*)(mb + 2048 + c); A[j] = gg * (sc + 1.0f); Bv[j] = *(const f32x4*)(mb + c); }
        f32x4 v[8], vn[8];
        { const f32x4* xr = (const f32x4*)(xin + (size_t)r0 * DM) + lane;
#pragma unroll
          for (int j = 0; j < 8; ++j) v[j] = __builtin_nontemporal_load(xr + 64 * j); }
        for (int r = r0; r < r0 + 16; ++r) {
            { const int rn = r + 1 < r0 + 16 ? r + 1 : r; const f32x4* xr = (const f32x4*)(xin + (size_t)rn * DM) + lane;
#pragma unroll
              for (int j = 0; j < 8; ++j) vn[j] = __builtin_nontemporal_load(xr + 64 * j); }
            float s = 0.f;
#pragma unroll
            for (int j = 0; j < 8; ++j) s += (v[j][0] * v[j][0] + v[j][1] * v[j][1]) + (v[j][2] * v[j][2] + v[j][3] * v[j][3]);
            const float rstd = rsqrtf(wave_sum(s) * (1.0f / DM) + EPS);
            u32x2* o8 = (u32x2*)(H + (size_t)r * DM) + lane;
#pragma unroll
            for (int j = 0; j < 8; ++j) { const f32x4 y = v[j] * rstd * A[j] + Bv[j]; u32x2 w; w.x = cvtpk(y[0], y[1]); w.y = cvtpk(y[2], y[3]); o8[64 * j] = w; }
#pragma unroll
            for (int j = 0; j < 8; ++j) v[j] = vn[j];
        }
    }
}
__device__ __forceinline__ void norm_mod_pass_bf(const bf16_t* xin, const float* g, const float* modl, bf16_t* H) {
    int tid = threadIdx.x; asm volatile("" : "+v"(tid));
    const int lane = tid & 63, wave = tid >> 6, gw = blockIdx.x * NWAVES + wave, NGW = gridDim.x * NWAVES;
    for (int r0 = gw * 16; r0 < T; r0 += NGW * 16) {
        const float* mb = modl + (size_t)(r0 / SEQ) * 6144;
        f32x4 A[8], Bv[8];
#pragma unroll
        for (int j = 0; j < 4; ++j)
#pragma unroll
            for (int q = 0; q < 2; ++q) { const int c = 8 * (64 * j + lane) + 4 * q; const f32x4 gg = *(const f32x4*)(g + c), sc = *(const f32x4*)(mb + 2048 + c); A[2 * j + q] = gg * (sc + 1.0f); Bv[2 * j + q] = *(const f32x4*)(mb + c); }
        u32x4 v[4], vn[4];
        { const u32x4* xr = (const u32x4*)(xin + (size_t)r0 * DM) + lane;
#pragma unroll
          for (int j = 0; j < 4; ++j) v[j] = __builtin_nontemporal_load(xr + 64 * j); }
        for (int r = r0; r < r0 + 16; ++r) {
            { const int rn = r + 1 < r0 + 16 ? r + 1 : r; const u32x4* xr = (const u32x4*)(xin + (size_t)rn * DM) + lane;
#pragma unroll
              for (int j = 0; j < 4; ++j) vn[j] = __builtin_nontemporal_load(xr + 64 * j); }
            f32x4 f[8]; float s = 0.f;
#pragma unroll
            for (int j = 0; j < 4; ++j) { f[2 * j] = (f32x4){bflo(v[j].x), bfhi(v[j].x), bflo(v[j].y), bfhi(v[j].y)}; f[2 * j + 1] = (f32x4){bflo(v[j].z), bfhi(v[j].z), bflo(v[j].w), bfhi(v[j].w)}; }
#pragma unroll
            for (int j = 0; j < 8; ++j) s += (f[j][0] * f[j][0] + f[j][1] * f[j][1]) + (f[j][2] * f[j][2] + f[j][3] * f[j][3]);
            const float rstd = rsqrtf(wave_sum(s) * (1.0f / DM) + EPS);
            u32x4* o8 = (u32x4*)(H + (size_t)r * DM) + lane;
#pragma unroll
            for (int j = 0; j < 4; ++j) { const f32x4 y0 = f[2 * j] * rstd * A[2 * j] + Bv[2 * j], y1 = f[2 * j + 1] * rstd * A[2 * j + 1] + Bv[2 * j + 1];
                u32x4 w; w.x = cvtpk(y0[0], y0[1]); w.y = cvtpk(y0[2], y0[3]); w.z = cvtpk(y1[0], y1[1]); w.w = cvtpk(y1[2], y1[3]); o8[64 * j] = w; }
#pragma unroll
            for (int j = 0; j < 4; ++j) v[j] = vn[j];
        }
    }
}
__device__ __forceinline__ void groupnorm_pass(const bf16_t* O, bf16_t* SG) {
    int tid = threadIdx.x; asm volatile("" : "+v"(tid));
    const int lane = tid & 63, wave = tid >> 6, gw = blockIdx.x * NWAVES + wave, NGW = gridDim.x * NWAVES;
    u32x4 ovv[8], gvv[8], ovn[8], gvn[8];
    if (gw < T) { const size_t off0 = (size_t)gw * 4096 + lane * 8;
#pragma unroll
        for (int hh = 0; hh < 8; ++hh) { ovv[hh] = __builtin_nontemporal_load((const u32x4*)(O + off0 + hh * 512)); gvv[hh] = __builtin_nontemporal_load((const u32x4*)(SG + off0 + hh * 512)); } }
    for (int r = gw; r < T; r += NGW) {
        const size_t off0 = (size_t)r * 4096 + lane * 8;
        { const int rn = r + NGW < T ? r + NGW : r; const size_t offn = (size_t)rn * 4096 + lane * 8;
#pragma unroll
          for (int hh = 0; hh < 8; ++hh) { ovn[hh] = __builtin_nontemporal_load((const u32x4*)(O + offn + hh * 512)); gvn[hh] = __builtin_nontemporal_load((const u32x4*)(SG + offn + hh * 512)); } }
#pragma unroll
        for (int hh = 0; hh < 8; ++hh) {
            const u32x4 ov = ovv[hh], gv = gvv[hh];
            float v[8] = {bflo(ov.x), bfhi(ov.x), bflo(ov.y), bfhi(ov.y), bflo(ov.z), bfhi(ov.z), bflo(ov.w), bfhi(ov.w)};
            const float gg[8] = {bflo(gv.x), bfhi(gv.x), bflo(gv.y), bfhi(gv.y), bflo(gv.z), bfhi(gv.z), bflo(gv.w), bfhi(gv.w)};
            float s = 0.f;
#pragma unroll
            for (int j = 0; j < 8; ++j) s += v[j];
            const float mu = wave_sum(s) * (1.0f / 512.0f); float q = 0.f;
#pragma unroll
            for (int j = 0; j < 8; ++j) { v[j] -= mu; q += v[j] * v[j]; }
            const float rstd = rsqrtf(wave_sum(q) * (1.0f / 512.0f) + EPS);
            u32x4 w; w.x = cvtpk(v[0] * rstd * gg[0], v[1] * rstd * gg[1]); w.y = cvtpk(v[2] * rstd * gg[2], v[3] * rstd * gg[3]);
            w.z = cvtpk(v[4] * rstd * gg[4], v[5] * rstd * gg[5]); w.w = cvtpk(v[6] * rstd * gg[6], v[7] * rstd * gg[7]);
            *(u32x4*)(SG + off0 + hh * 512) = w;
        }
#pragma unroll
        for (int hh = 0; hh < 8; ++hh) { ovv[hh] = ovn[hh]; gvv[hh] = gvn[hh]; }
    }
}
__device__ __forceinline__ void final_norm_pass(const bf16_t* x2, float* xo, const float* g) {
    int tid = threadIdx.x; asm volatile("" : "+v"(tid));
    const int  lane = tid & 63, wave = tid >> 6, gw = blockIdx.x * NWAVES + wave, NGW = gridDim.x * NWAVES;
    f32x4 A[8];
#pragma unroll
    for (int j = 0; j < 4; ++j) { A[2 * j] = *(const f32x4*)(g + 8 * (64 * j + lane)); A[2 * j + 1] = *(const f32x4*)(g + 8 * (64 * j + lane) + 4); }
    u32x4 v[4], vn[4];
    if (gw < T) { const u32x4* xr = (const u32x4*)(x2 + (size_t)gw * DM) + lane;
#pragma unroll
        for (int j = 0; j < 4; ++j) v[j] = __builtin_nontemporal_load(xr + 64 * j); }
    for (int r = gw; r < T; r += NGW) {
        { const int rn = r + NGW < T ? r + NGW : r; const u32x4* xn = (const u32x4*)(x2 + (size_t)rn * DM) + lane;
#pragma unroll
          for (int j = 0; j < 4; ++j) vn[j] = __builtin_nontemporal_load(xn + 64 * j); }
        f32x4 f[8]; float s = 0.f;
#pragma unroll
        for (int j = 0; j < 4; ++j) { f[2 * j] = (f32x4){bflo(v[j].x), bfhi(v[j].x), bflo(v[j].y), bfhi(v[j].y)}; f[2 * j + 1] = (f32x4){bflo(v[j].z), bfhi(v[j].z), bflo(v[j].w), bfhi(v[j].w)}; }
#pragma unroll
        for (int j = 0; j < 8; ++j) s += (f[j][0] * f[j][0] + f[j][1] * f[j][1]) + (f[j][2] * f[j][2] + f[j][3] * f[j][3]);
        const float rstd = rsqrtf(wave_sum(s) * (1.0f / DM) + EPS);
        f32x4* xr = (f32x4*)(xo + (size_t)r * DM) + 2 * lane;
#pragma unroll
        for (int j = 0; j < 4; ++j) { xr[128 * j] = f[2 * j] * rstd * A[2 * j]; xr[128 * j + 1] = f[2 * j + 1] * rstd * A[2 * j + 1]; }
#pragma unroll
        for (int j = 0; j < 4; ++j) v[j] = vn[j];
    }
}

#define XB_TMO      128
#define XB_XCNT(j)  (256  + 64 * (j))
#define XB_XSUB(j)  (1280 + 64 * (j))
#define XB_XGEN(j)  (2304 + 64 * (j))
#define XB_TOP      3328
#define XB_TOPGEN   3392
#define XCD_BAR_WORDS 3456
#define XB_SPIN_CAP (1u << 18)

__device__ __forceinline__ unsigned xb_ld(unsigned* p)              { return __hip_atomic_load(p, __ATOMIC_RELAXED, __HIP_MEMORY_SCOPE_AGENT); }
__device__ __forceinline__ unsigned xb_add(unsigned* p, unsigned v) { return __hip_atomic_fetch_add(p, v, __ATOMIC_RELAXED, __HIP_MEMORY_SCOPE_AGENT); }
__device__ __forceinline__ unsigned xb_xcc_id() { return (unsigned)__builtin_amdgcn_s_getreg((3 << 11) | 20) & 0xFu; }
#define XB_SPIN(cond, bar) do { unsigned _sp = 0; while (cond) { __builtin_amdgcn_s_sleep(1); \
    if ((++_sp & 255u) == 0u) { if (xb_ld(&(bar)[XB_TMO])) break; if (_sp > XB_SPIN_CAP) { atomicAdd(&(bar)[XB_TMO], 1u); break; } } } } while (0)

struct XcdBarrier {
    unsigned* bar; unsigned x;
    volatile LAS unsigned* st;
};

__device__ __forceinline__ XcdBarrier xcd_barrier_post(unsigned* bar, volatile LAS unsigned* st) {
    XcdBarrier b; b.bar = bar; b.x = xb_xcc_id(); b.st = st;
    if (threadIdx.x == 0) (void)xb_add(&bar[XB_XCNT(b.x)], 1u);
    return b;
}
__device__ __forceinline__ void xcd_barrier_complete(unsigned* bar, unsigned x, unsigned& nloc, unsigned& nx) {
    const unsigned G = gridDim.x * gridDim.y * gridDim.z;
    unsigned sum, cnt, mine, sp = 0u;
    for (;;) {
        sum = 0u; cnt = 0u; mine = 0u;
#pragma unroll
        for (unsigned j = 0; j < 16; ++j) { const unsigned c = xb_ld(&bar[XB_XCNT(j)]); sum += c; cnt += (c > 0u) ? 1u : 0u; mine = (j == x) ? c : mine; }
        if (sum == G) break;
        __builtin_amdgcn_s_sleep(1);
        if ((++sp & 255u) == 0u) { if (xb_ld(&bar[XB_TMO])) break; if (sp > XB_SPIN_CAP) { atomicAdd(&bar[XB_TMO], 1u); break; } }
    }
    nloc = mine > 0u ? mine : 1u; nx = cnt > 0u ? cnt : 1u;
}

__device__ __forceinline__ void xcd_barrier(const XcdBarrier& b) {
    asm volatile("s_waitcnt vmcnt(0)" ::: "memory");
    __syncthreads();
    if (threadIdx.x == 0) {
        unsigned* bar = b.bar;
        __builtin_amdgcn_s_waitcnt(0);
        unsigned nloc = b.st[0], nx = b.st[1];
        if (nloc == 0u) { xcd_barrier_complete(bar, b.x, nloc, nx); b.st[0] = nloc; b.st[1] = nx; }
        const unsigned old = xb_add(&bar[XB_XSUB(b.x)], 1u);
        const unsigned gen = old / nloc;
        if (old + 1u == (gen + 1u) * nloc) {
            __builtin_amdgcn_fence(__ATOMIC_RELEASE, "agent");
            asm volatile("s_waitcnt vmcnt(0)" ::: "memory");
            const unsigned og = xb_add(&bar[XB_TOP], 1u);
            const unsigned tg = og / nx;
            if (og + 1u == (tg + 1u) * nx) xb_add(&bar[XB_TOPGEN], 1u);
            else XB_SPIN(xb_ld(&bar[XB_TOPGEN]) == tg, bar);
            __builtin_amdgcn_fence(__ATOMIC_ACQUIRE, "agent");
            xb_add(&bar[XB_XGEN(b.x)], 1u);
            asm volatile("s_waitcnt vmcnt(0)" ::: "memory");
        } else {
            XB_SPIN(xb_ld(&bar[XB_XGEN(b.x)]) == gen, bar);
            __builtin_amdgcn_fence(__ATOMIC_ACQUIRE, "agent");
            asm volatile("s_waitcnt vmcnt(0)" ::: "memory");
        }
    }
    __syncthreads();
}

constexpr int N_PHASES = 12;
constexpr size_t CTL_BAR = 640 * 1024, CTL_BAR_BYTES = 32 * 1024;
constexpr int LDS_BARST = 139264;

__global__ void __launch_bounds__(NTHREADS, 2) fwd_kernel(Args a) {
    extern __shared__ __attribute__((aligned(16))) unsigned char lds_raw[];
    LAS unsigned char* lds = (LAS unsigned char*)lds_raw;
    cg::grid_group grid = cg::this_grid();
    unsigned char* ws = a.ws; const int G = gridDim.x;
    float* mod = (float*)(ws + WS_CTL + CTL_MOD); float* ssq_q = (float*)(ws + WS_CTL + CTL_SSQQ); float* ssq_kv = (float*)(ws + WS_CTL + CTL_SSQKV);
    bf16_t* H = (bf16_t*)(ws + WS_H);
    if (threadIdx.x < 4) ((LAS unsigned*)(lds + LDS_BARST))[threadIdx.x] = 0u;
    __syncthreads();
    const XcdBarrier xbar = xcd_barrier_post((unsigned*)(ws + WS_CTL + CTL_BAR) + a.li * XCD_BAR_WORDS, (volatile LAS unsigned*)(lds + LDS_BARST));
    if (a.ph_lo < 0) grid.sync();
#ifndef PH_MASK
#define PH_MASK 0xFFF
#endif
#define IN(k) (((PH_MASK >> (k)) & 1) && a.ph_lo <= (k) && (k) < a.ph_hi)
#define SEAM(k) do { if (IN(k) && IN((k) + 1)) xcd_barrier(xbar); } while (0)
#ifdef PROBE_SYNCS
    if (a.ph_lo == 0) for (int i_ = 0; i_ < PROBE_SYNCS; ++i_) xcd_barrier(xbar);
#endif
    if (IN(0)) { prologue(a, lds); } SEAM(0);
    if (IN(1)) { norm_mod_pass(a.x, a.norm_g, mod, H); } SEAM(1);
    if (IN(2)) {
        pg8::Gemm g{H, (const bf16_t*)(ws + WS_WRIN), T, RET_IN, DM}; pg8::StaticOrder S; S.init(T, RET_IN, G, (int)blockIdx.x);
        pg8::EpiRetIn E{(bf16_t*)(ws + WS_Q), (bf16_t*)(ws + WS_K), (bf16_t*)(ws + WS_V), (bf16_t*)(ws + WS_SG), a.pos};
        pg8::gemm_phase<pg8::EpiRetIn, pg8::StaticOrder, true, true>(lds, g, S, E);
    } SEAM(2);
    if (IN(3)) {
        ret::retp_phase((LAS char*)lds, (const bf16_t*)(ws + WS_Q), (bf16_t*)(ws + WS_K), (bf16x8*)H);
        xcd_barrier(xbar);
        ret::ret_phase((LAS char*)lds, (const bf16_t*)(ws + WS_Q), (const bf16_t*)(ws + WS_K), (const bf16_t*)(ws + WS_V), (bf16_t*)a.out, (const bf16x8*)H);
#ifdef PROBE_REP_SCAN
        ret::ret_phase((LAS char*)lds, (const bf16_t*)(ws + WS_Q), (const bf16_t*)(ws + WS_K), (const bf16_t*)(ws + WS_V), (bf16_t*)a.out, (const bf16x8*)H);
#endif
    } SEAM(3);
    if (IN(4)) { groupnorm_pass((const bf16_t*)a.out, (bf16_t*)(ws + WS_SG)); } SEAM(4);
    if (IN(5)) {
        pg8::Gemm g{(const bf16_t*)(ws + WS_SG), (const bf16_t*)(ws + WS_WROUT), T, DM, RET_W}; pg8::StaticOrder S; S.init(T, DM, G, (int)blockIdx.x);
        pg8::EpiResidBf E{a.x, (bf16_t*)a.out, mod + 4096};
        pg8::gemm_phase<pg8::EpiResidBf, pg8::StaticOrder, true, true>(lds, g, S, E);
    } SEAM(5);
    if (IN(6)) { norm_mod_pass_bf((const bf16_t*)a.out, a.norm_g + DM, mod + 4 * 6144, H); } SEAM(6);
    if (IN(7)) {
        pg8::Gemm g{H, (const bf16_t*)(ws + WS_WMIN), T, MLA_INP, DM}; pg8::StaticOrder S; S.init(T, MLA_INP, G, (int)blockIdx.x);
        pg8::EpiMlaIn E{(bf16_t*)(ws + WS_CQ), (bf16_t*)(ws + WS_CKV), (bf16_t*)(ws + WS_SG1), (bf16_t*)(ws + WS_KR), ssq_q, ssq_kv, a.pos};
        pg8::gemm_phase<pg8::EpiMlaIn, pg8::StaticOrder, true, true>(lds, g, S, E);
    } SEAM(7);
    if (IN(8)) {
        { pg8::Gemm g{(const bf16_t*)(ws + WS_CQ), (const bf16_t*)(ws + WS_WUQ), T, 3072, 512}; pg8::StaticOrder S; S.init(T, 3072, G, (int)blockIdx.x);
          pg8::EpiQUp E{(bf16_t*)(ws + WS_QN), (bf16_t*)(ws + WS_QRP), ssq_q, a.pos};
          pg8::gemm_phase<pg8::EpiQUp, pg8::StaticOrder, true, true>(lds, g, S, E); }
        { pg8::Gemm g{(const bf16_t*)(ws + WS_CKV), (const bf16_t*)(ws + WS_WUKV), T, 4096, 512}; pg8::StaticOrder S; S.init(T, 4096, G, (int)blockIdx.x);
          pg8::EpiKvUp E{(bf16_t*)(ws + WS_KN), (bf16_t*)(ws + WS_V1), ssq_kv};
          pg8::gemm_phase<pg8::EpiKvUp, pg8::StaticOrder, true, true>(lds, g, S, E); }
    } SEAM(8);
    if (IN(9)) {
        const att::Tensors Tn{(const bf16_t*)(ws + WS_QN), (const bf16_t*)(ws + WS_QRP), (const bf16_t*)(ws + WS_KN), (const bf16_t*)(ws + WS_KR), (const bf16_t*)(ws + WS_V1), (const bf16_t*)(ws + WS_SG1), H};
        att::attn_phase((char*)lds_raw, Tn);
    } SEAM(9);
    if (IN(10)) {
        pg8::Gemm g{H, (const bf16_t*)(ws + WS_WMOUT), T, DM, MLA_W}; pg8::StaticOrder S; S.init(T, DM, G, (int)blockIdx.x);
        pg8::EpiResidBf2 E{(const bf16_t*)a.out, (bf16_t*)(ws + WS_QN), mod + 4 * 6144 + 4096};
        pg8::gemm_phase<pg8::EpiResidBf2, pg8::StaticOrder, true, true>(lds, g, S, E);
    } SEAM(10);
    if (IN(11)) { final_norm_pass((const bf16_t*)(ws + WS_QN), a.out, a.final_g); }
#undef IN
#undef SEAM
}

#ifndef MK_LAUNCHES
#define MK_LAUNCHES 1
#endif
extern "C" void kernel_launch(void* const* d_in, const int* in_sizes, int n_in, void* d_out, int out_size, void* d_ws, size_t ws_size, hipStream_t stream) {
    static int grid = 0;
    if (grid == 0) {
        if (n_in != 16 || in_sizes[0] != T * DM || out_size != T * DM || ws_size < WS_END) {
            fprintf(stderr, "kernel_launch: unexpected shapes (n_in %d, in0 %d, out %d, ws %zu); nothing launched\n", n_in, n_in > 0 ? in_sizes[0] : -1, out_size, ws_size); grid = -1; return; }
        int dev = 0, cus = 0, per_cu = 0;
        (void)hipGetDevice(&dev); (void)hipDeviceGetAttribute(&cus, hipDeviceAttributeMultiprocessorCount, dev);
        if (hipFuncSetAttribute((const void*)fwd_kernel, hipFuncAttributeMaxDynamicSharedMemorySize, LDS_BYTES) != hipSuccess) { fprintf(stderr, "kernel_launch: hipFuncSetAttribute failed\n"); grid = -1; return; }
        if (hipOccupancyMaxActiveBlocksPerMultiprocessor(&per_cu, (const void*)fwd_kernel, NTHREADS, LDS_BYTES) != hipSuccess || per_cu < 1) { fprintf(stderr, "kernel_launch: occupancy query says %d blocks/CU\n", per_cu); per_cu = 1; }
        (void)hipGetLastError();
        grid = cus > 0 ? cus : 256;
    }
    if (grid < 0) return;
    Args a{};
    a.x = (const float*)d_in[0]; a.c = (const float*)d_in[1]; a.pos = (const int*)d_in[2]; a.ada_w = (const float*)d_in[3]; a.ada_b = (const float*)d_in[4]; a.norm_g = (const float*)d_in[5];
    a.ret_w_in = (const float*)d_in[6]; a.ret_gn_g = (const float*)d_in[7]; a.ret_w_out = (const float*)d_in[8]; a.mla_w_in = (const float*)d_in[9]; a.mla_qn_g = (const float*)d_in[10];
    a.mla_w_uq = (const float*)d_in[11]; a.mla_kvn_g = (const float*)d_in[12]; a.mla_w_ukv = (const float*)d_in[13]; a.mla_w_out = (const float*)d_in[14]; a.final_g = (const float*)d_in[15];
    a.out = (float*)d_out; a.ws = (unsigned char*)d_ws;
    if (MK_LAUNCHES == 1) {
        if (hipMemsetAsync((unsigned char*)d_ws + WS_CTL + CTL_BAR, 0, CTL_BAR_BYTES, stream) != hipSuccess) { fprintf(stderr, "kernel_launch: memset of the barrier words failed\n"); return; }
#ifdef PROBE_REP_PHASE
        const int cuts[3] = {0, PROBE_REP_PHASE + 1, N_PHASES};
        for (int li = 0; li < 2; ++li) { a.ph_lo = li ? PROBE_REP_PHASE : 0; a.ph_hi = cuts[li + 1]; a.li = li; void* args[] = {&a};
            const hipError_t e = hipLaunchCooperativeKernel((const void*)fwd_kernel, dim3(grid), dim3(NTHREADS), args, LDS_BYTES, stream);
            if (e != hipSuccess) fprintf(stderr, "kernel_launch: cooperative launch failed: %s (grid %d)\n", hipGetErrorString(e), grid); }
#else
        a.ph_lo = 0; a.ph_hi = N_PHASES;
        void* args[] = {&a};
        const hipError_t e = hipLaunchCooperativeKernel((const void*)fwd_kernel, dim3(grid), dim3(NTHREADS), args, LDS_BYTES, stream);
        if (e != hipSuccess) fprintf(stderr, "kernel_launch: cooperative launch failed: %s (grid %d)\n", hipGetErrorString(e), grid);
#endif
    } else {
        for (int p = 0; p < N_PHASES; ++p) { a.ph_lo = p; a.ph_hi = p + 1; hipLaunchKernelGGL(fwd_kernel, dim3(grid), dim3(NTHREADS), LDS_BYTES, stream, a); }
    }
}
```
